# Optimizing an MI355X kernel written in HIP

```python
import math
import jax
import jax.numpy as jnp
from jax import lax
import numpy as np

D_MODEL = 1024
BATCH = 2
SEQ = 16384
DEPTH = 2
DEC_BATCH = 4
DEC_SEQ = 4096
PAST_LEN = 128

GRID_W = 64
D_MIX = D_MODEL
N_MIXERS = 4
GROUP_W = D_MIX // N_MIXERS
HEAD_DIM = 64
GROUP_HEADS = GROUP_W // HEAD_DIM
EPS = 1e-6
SGU_CHUNK = 128
DN_HEADS = GROUP_HEADS
DN_DK = HEAD_DIM
DN_DV = HEAD_DIM
DN_CHUNK = 64
CONV_K = 5
DN_CONV_CH = DN_HEADS * (2 * DN_DK + DN_DV)
ATT_HEADS = GROUP_HEADS
ATT_KV_HEADS = 2
ATT_QBLOCK = 128
ROPE_THETA = 10000.0
ROPE_AXIS_DIM = HEAD_DIM // 2
ROPE_FREQS = ROPE_AXIS_DIM // 2
POOL_WINDOWS = (2, 4, 8, 16)
POOL_GROUP = GROUP_W // len(POOL_WINDOWS)

IN_WIDTHS = (
    GROUP_W, GROUP_W, GROUP_W,
    DN_HEADS * DN_DK, DN_HEADS * DN_DK, DN_HEADS * DN_DV,
    DN_HEADS * DN_DV, 2 * DN_HEADS, 2 * DN_HEADS,
    ATT_HEADS * HEAD_DIM, ATT_KV_HEADS * HEAD_DIM,
    ATT_KV_HEADS * HEAD_DIM, ATT_HEADS * HEAD_DIM,
    GROUP_W, GROUP_W,
)
IN_COLS = sum(IN_WIDTHS)

kernel_name = "hybrid_parallel_group_encoder"


def _rms(x):
    xf = x.astype(jnp.float32)
    return (xf * lax.rsqrt(jnp.mean(xf * xf, axis=-1, keepdims=True) + EPS)).astype(x.dtype)


def _rms_norm(x, w):
    return _rms(x) * w


def _l2norm(x):
    xf = x.astype(jnp.float32)
    return xf * lax.rsqrt(jnp.sum(xf * xf, axis=-1, keepdims=True) + EPS)


def _split_cols(proj):
    offsets = []
    acc = 0
    for width in IN_WIDTHS[:-1]:
        acc += width
        offsets.append(acc)
    return jnp.split(proj, offsets, axis=-1)


def _sgu_mixer(u, v, sgu_w, sgu_b):
    b_, s_, _ = u.shape
    nc = s_ // SGU_CHUNK
    v_n = _rms(v.reshape(b_, nc, SGU_CHUNK, GROUP_HEADS, HEAD_DIM))
    mixed = jnp.einsum("hij,bnjhd->bnihd", sgu_w, v_n) + sgu_b.T[:, :, None]
    out = u.reshape(b_, nc, SGU_CHUNK, GROUP_HEADS, HEAD_DIM) * mixed
    return out.reshape(b_, s_, GROUP_W)


def _centred_depthwise_conv(x, w):
    pad = CONV_K // 2
    s_ = x.shape[1]
    xp = jnp.pad(x, ((0, 0), (pad, pad), (0, 0)))
    return sum(xp[:, i:i + s_] * w[i] for i in range(CONV_K))


def _chunk_gated_delta_rule(q, k, v, g, beta):
    b_, s_, h_, dk = q.shape
    dv = v.shape[-1]
    n = s_ // DN_CHUNK

    def to_chunks(t):
        t = t.astype(jnp.float32).reshape(b_, n, DN_CHUNK, h_, *t.shape[3:])
        return jnp.moveaxis(t, 3, 2)

    q, k, v, g, beta = (to_chunks(t) for t in (q, k, v, g, beta))
    g = jnp.cumsum(g, axis=-1)
    idx = jnp.arange(DN_CHUNK)
    incl = idx[:, None] >= idx[None, :]
    strict = idx[:, None] > idx[None, :]
    decay = jnp.exp(jnp.where(incl, g[..., :, None] - g[..., None, :], -jnp.inf))
    k_beta = k * beta[..., None]
    v_beta = v * beta[..., None]
    lower = jnp.where(strict, jnp.einsum("bnhid,bnhjd->bnhij", k_beta, k) * decay, 0.0)
    eye = jnp.eye(DN_CHUNK, dtype=jnp.float32)
    t_mat = lax.linalg.triangular_solve(lower + eye, jnp.broadcast_to(eye, lower.shape),
                                        left_side=True, lower=True, unit_diagonal=True)
    u = t_mat @ v_beta
    w = t_mat @ (k_beta * jnp.exp(g)[..., None])
    intra = jnp.where(incl, jnp.einsum("bnhid,bnhjd->bnhij", q, k) * decay, 0.0)
    g_last = g[..., -1]
    q_dec = q * jnp.exp(g)[..., None]
    k_dec = k * jnp.exp(g_last[..., None] - g)[..., None]

    def step(state, xs):
        w_c, u_c, q_c, k_c, a_c, gl_c = xs
        v_new = u_c - w_c @ state
        out = q_c @ state + a_c @ v_new
        state = state * jnp.exp(gl_c)[..., None, None] + jnp.einsum("bhcd,bhce->bhde", k_c, v_new)
        return state, out

    xs = tuple(jnp.moveaxis(t, 1, 0) for t in (w, u, q_dec, k_dec, intra, g_last))
    state0 = jnp.zeros((b_, h_, dk, dv), jnp.float32)
    _, out = lax.scan(step, state0, xs)
    return jnp.transpose(out, (1, 0, 3, 2, 4)).reshape(b_, s_, h_, dv)


def _deltanet_mixer(q, k, v, beta_raw, alpha_raw, conv_w, a_log, dt_bias, norm_w):
    b_, s_, _ = q.shape
    qkv = jax.nn.silu(_centred_depthwise_conv(jnp.concatenate([q, k, v], axis=-1), conv_w))
    q, k, v = jnp.split(qkv, [DN_HEADS * DN_DK, 2 * DN_HEADS * DN_DK], axis=-1)
    q = _l2norm(q.reshape(b_, s_, DN_HEADS, DN_DK)) * (DN_DK ** -0.5)
    k = _l2norm(k.reshape(b_, s_, DN_HEADS, DN_DK))
    v = v.reshape(b_, s_, DN_HEADS, DN_DV)
    beta = jax.nn.sigmoid(beta_raw.astype(jnp.float32)).reshape(b_, s_, 2, DN_HEADS)
    g = -jnp.exp(a_log) * jax.nn.softplus(alpha_raw.astype(jnp.float32).reshape(b_, s_, 2, DN_HEADS) + dt_bias)
    o_fwd = _chunk_gated_delta_rule(q, k, v, g[:, :, 0], beta[:, :, 0])
    flip = lambda t: jnp.flip(t, axis=1)
    o_bwd = flip(_chunk_gated_delta_rule(flip(q), flip(k), flip(v), flip(g[:, :, 1]), flip(beta[:, :, 1])))
    o = _rms_norm(o_fwd + o_bwd, norm_w)
    return o.reshape(b_, s_, DN_HEADS * DN_DV)


def _axial_rope_tables(seq_len):
    n_rows = seq_len // GRID_W
    rows = jnp.repeat(jnp.arange(n_rows), GRID_W)
    cols = jnp.tile(jnp.arange(GRID_W), n_rows)
    inv_freq = jnp.power(ROPE_THETA, -2.0 * jnp.arange(ROPE_FREQS, dtype=jnp.float32) / ROPE_AXIS_DIM)
    ang = jnp.stack([rows, cols], axis=-1).astype(jnp.float32)[:, :, None] * inv_freq
    return jnp.cos(ang), jnp.sin(ang)


def _apply_axial_rope(x, cos, sin):
    b_, s_, h_, d_ = x.shape
    xr = x.reshape(b_, s_, h_, 2, 2, ROPE_FREQS)
    x1, x2 = xr[..., 0, :], xr[..., 1, :]
    c = cos[None, :, None]
    s = sin[None, :, None]
    out = jnp.stack([x1 * c - x2 * s, x2 * c + x1 * s], axis=-2)
    return out.reshape(b_, s_, h_, d_).astype(x.dtype)


def _attention_mixer(q, k, v, q_norm_w, k_norm_w, cos, sin):
    b_, s_, _ = q.shape
    grp = ATT_HEADS // ATT_KV_HEADS
    q = _apply_axial_rope(_rms_norm(q.reshape(b_, s_, ATT_HEADS, HEAD_DIM), q_norm_w), cos, sin)
    k = _apply_axial_rope(_rms_norm(k.reshape(b_, s_, ATT_KV_HEADS, HEAD_DIM), k_norm_w), cos, sin)
    v = v.reshape(b_, s_, ATT_KV_HEADS, HEAD_DIM)
    nb = s_ // ATT_QBLOCK
    qb = q.reshape(b_, nb, ATT_QBLOCK, ATT_KV_HEADS, grp, HEAD_DIM).transpose(1, 0, 2, 3, 4, 5)
    scale = HEAD_DIM ** -0.5

    def one_block(q_blk):
        s = jnp.einsum("bqkgd,bskd->bkgqs", q_blk, k, preferred_element_type=jnp.float32) * scale
        p = jax.nn.softmax(s, axis=-1)
        return jnp.einsum("bkgqs,bskd->bqkgd", p.astype(v.dtype), v)

    o = lax.map(one_block, qb)
    return o.transpose(1, 0, 2, 3, 4, 5).reshape(b_, s_, ATT_HEADS * HEAD_DIM)


def _pool_mixer(x, pool_w, pool_scale):
    b_, s_, _ = x.shape
    ng = len(POOL_WINDOWS)
    xf = x.astype(jnp.float32).reshape(b_, s_, ng, POOL_GROUP)
    csum = jnp.concatenate([jnp.zeros((b_, 1, ng, POOL_GROUP), jnp.float32), jnp.cumsum(xf, axis=1)], axis=1)
    t = jnp.arange(s_)
    diffs = []
    for gi, win in enumerate(POOL_WINDOWS):
        lo = jnp.clip(t - win // 2, 0, s_)
        hi = jnp.clip(t + win // 2, 0, s_)
        c_g = csum[:, :, gi]
        mean = (jnp.take(c_g, hi, axis=1) - jnp.take(c_g, lo, axis=1)) / (hi - lo).astype(jnp.float32)[None, :, None]
        diffs.append(mean - xf[:, :, gi])
    d = jnp.stack(diffs, axis=2)
    y = jnp.einsum("bsgc,gcd->bsgd", d, pool_w).reshape(b_, s_, GROUP_W) * pool_scale
    return y


def _layer(x, cos, sin, norm_w, w_in, sgu_w, sgu_b, conv_w, a_log, dt_bias, dn_norm_w,
           q_norm_w, k_norm_w, pool_w, pool_scale, w_out):
    h = _rms_norm(x, norm_w)
    proj = h @ w_in
    (a_u, a_v, a_z, b_q, b_k, b_v, b_z, b_beta, b_alpha,
     c_q, c_k, c_v, c_z, d_x, d_z) = _split_cols(proj)
    y_a = _sgu_mixer(a_u, a_v, sgu_w, sgu_b) * jax.nn.silu(a_z)
    y_b = _deltanet_mixer(b_q, b_k, b_v, b_beta, b_alpha, conv_w, a_log, dt_bias, dn_norm_w) * jax.nn.silu(b_z)
    y_c = _attention_mixer(c_q, c_k, c_v, q_norm_w, k_norm_w, cos, sin) * jax.nn.silu(c_z)
    y_d = _pool_mixer(d_x, pool_w, pool_scale) * jax.nn.silu(d_z)
    mix = jnp.concatenate([y_a.astype(x.dtype), y_b.astype(x.dtype), y_c.astype(x.dtype), y_d.astype(x.dtype)], axis=-1)
    return (x + mix @ w_out).astype(x.dtype)


def setup_inputs(seed: int = 0) -> dict:
    key = jax.random.key(seed)
    ks = jax.random.split(key, 16)
    f32 = jnp.float32

    def nrm(k, shape, scale):
        return jax.random.normal(k, shape, f32) * scale

    def gain(k, shape):
        return 1.0 + 0.02 * jax.random.normal(k, shape, f32)

    dt = jnp.exp(jax.random.uniform(ks[8], (DEPTH, 2, DN_HEADS), f32, math.log(1e-3), math.log(1e-1)))
    return {
        "x_prompt": nrm(ks[0], (BATCH, SEQ, D_MODEL), 1.0),
        "x_sample": nrm(ks[1], (DEC_BATCH, DEC_SEQ, D_MODEL), 1.0),
        "norm_w": gain(ks[2], (DEPTH, D_MODEL)),
        "w_in": nrm(ks[3], (DEPTH, D_MODEL, IN_COLS), D_MODEL ** -0.5),
        "sgu_w": nrm(ks[4], (DEPTH, GROUP_HEADS, SGU_CHUNK, SGU_CHUNK), SGU_CHUNK ** -0.5),
        "sgu_b": gain(ks[5], (DEPTH, GROUP_HEADS, SGU_CHUNK)),
        "conv_w": nrm(ks[6], (DEPTH, CONV_K, DN_CONV_CH), CONV_K ** -0.5),
        "a_log": jnp.log(jax.random.uniform(ks[7], (DEPTH, 2, DN_HEADS), f32, 1.0, 16.0)),
        "dt_bias": dt + jnp.log(-jnp.expm1(-dt)),
        "dn_norm_w": gain(ks[9], (DEPTH, DN_DV)),
        "q_norm_w": gain(ks[10], (DEPTH, HEAD_DIM)),
        "k_norm_w": gain(ks[11], (DEPTH, HEAD_DIM)),
        "pool_w": nrm(ks[12], (DEPTH, len(POOL_WINDOWS), POOL_GROUP, POOL_GROUP), POOL_GROUP ** -0.5),
        "pool_scale": gain(ks[13], (DEPTH, GROUP_W)),
        "w_out": nrm(ks[14], (DEPTH, D_MIX, D_MODEL), D_MIX ** -0.5),
    }


def reference(x_prompt, x_sample, norm_w, w_in, sgu_w, sgu_b, conv_w, a_log, dt_bias, dn_norm_w,
              q_norm_w, k_norm_w, pool_w, pool_scale, w_out):
    cos_p, sin_p = _axial_rope_tables(x_prompt.shape[1])
    cos_s, sin_s = _axial_rope_tables(x_sample.shape[1])
    y_prompt = x_prompt
    y_sample = x_sample
    for l in range(DEPTH):
        layer_params = (norm_w[l], w_in[l], sgu_w[l], sgu_b[l], conv_w[l], a_log[l], dt_bias[l],
                        dn_norm_w[l], q_norm_w[l], k_norm_w[l], pool_w[l], pool_scale[l], w_out[l])
        y_prompt = _layer(y_prompt, cos_p, sin_p, *layer_params)
        y_sample = _layer(y_sample, cos_s, sin_s, *layer_params)
    return (y_prompt, y_sample)
```

```cpp
#include <hip/hip_runtime.h>
#include <hip/hip_cooperative_groups.h>
#include <cstdio>
#include <cstdint>
namespace cg = cooperative_groups;

#define DI __device__ __forceinline__
#define LAS __attribute__((address_space(3)))

typedef unsigned short bf16_t;
typedef short bf16x8 __attribute__((ext_vector_type(8)));
typedef short s16x4 __attribute__((ext_vector_type(4)));
typedef float f32x2 __attribute__((ext_vector_type(2)));
typedef float f32x4 __attribute__((ext_vector_type(4)));
typedef float f32x16 __attribute__((ext_vector_type(16)));
typedef unsigned u32x2 __attribute__((ext_vector_type(2)));
typedef unsigned u32x4 __attribute__((ext_vector_type(4)));
typedef __bf16 bfv2 __attribute__((ext_vector_type(2)));

constexpr int T_TOK = 49152, T_PROMPT = 32768;
constexpr int PP = 3136;
constexpr int NV = 3088;
constexpr int A_U = 0, A_V = 256, A_Z = 512, B_Q = 768, B_K = 1024, B_V = 1280, B_Z = 1536,
              C_Q = 1792, C_K = 2048, C_V = 2176, C_Z = 2304, D_X = 2560, D_Z = 2816, B_BETA = 3072, B_ALPHA = 3080;
__host__ __device__ constexpr int refcol(int n) { return n < 1792 ? n : (n < 3072 ? n + 16 : 1792 + (n - 3072)); }
constexpr float EPSF = 1e-6f;

constexpr size_t WS_WIN = 0;
constexpr size_t WS_WOUT = 13107200;
constexpr size_t WS_SGUW = 17301504;
constexpr size_t WS_POOLW = 17563648;
constexpr size_t WS_ROPE = 17629184;
constexpr size_t WS_SSQ = 17661952;
constexpr size_t WS_LBUF = 18055168;
constexpr size_t WS_CNT = 21200896;
constexpr size_t WS_PROJ = 21201152;
constexpr size_t WS_OPS = WS_PROJ + (size_t)T_TOK * PP * 2;
constexpr size_t OPS_STRIDE = 66560;
constexpr size_t WS_BAR = WS_OPS + 3072 * OPS_STRIDE;
constexpr size_t WS_END = WS_BAR + 16384;
constexpr int LDS_BYTES = 73728 + 64;
constexpr int N_ATT_UNITS = 2304;

struct Params {
  const float* x_prompt; const float* x_sample; const float* norm_w; const float* w_in; const float* sgu_w; const float* sgu_b;
  const float* conv_w; const float* a_log; const float* dt_bias; const float* dn_norm_w; const float* q_norm_w; const float* k_norm_w;
  const float* pool_w; const float* pool_scale; const float* w_out;
  float* out; unsigned char* ws;
  int ph_lo, ph_hi, coop, pad;
};

DI float bf2f(bf16_t v) { return __uint_as_float((unsigned)v << 16); }
DI float bflo(unsigned u) { return __uint_as_float(u << 16); }
DI float bfhi(unsigned u) { return __uint_as_float(u & 0xffff0000u); }
DI unsigned pk2(float lo, float hi) { f32x2 v = {lo, hi}; bfv2 b = __builtin_convertvector(v, bfv2); return __builtin_bit_cast(unsigned, b); }
DI bf16_t f2bf(float x) { return (bf16_t)(pk2(x, 0.f) & 0xffffu); }
DI bf16x8 pack8(f32x4 a, f32x4 b) { u32x4 w = {pk2(a.x, a.y), pk2(a.z, a.w), pk2(b.x, b.y), pk2(b.z, b.w)}; return __builtin_bit_cast(bf16x8, w); }
DI float silu(float x) { return x * __builtin_amdgcn_rcpf(1.f + __expf(-x)); }
DI unsigned xb_xcc_id() { return (unsigned)__builtin_amdgcn_s_getreg((3 << 11) | 20) & 0xFu; }
DI int crow(int i, int h) { return (i & 3) + 8 * (i >> 2) + 4 * h; }
DI f32x16 mfma32(bf16x8 a, bf16x8 b, f32x16 c) { return __builtin_amdgcn_mfma_f32_32x32x16_bf16(a, b, c, 0, 0, 0); }
DI f32x4 mfma16(bf16x8 a, bf16x8 b, f32x4 c) { return __builtin_amdgcn_mfma_f32_16x16x32_bf16(a, b, c, 0, 0, 0); }
DI int swz_chunk(int row, int kc) { return row * 4 + (kc ^ ((row >> 2) & 3)); }
DI size_t tidxA(int row, int k) { return ((size_t)(row >> 8) * 32 + (k >> 5)) * 8192 + (size_t)(swz_chunk(row & 255, (k & 31) >> 3) * 8 + (k & 7)); }
DI size_t tidxB(int n, int k) { return ((size_t)(n >> 7) * 32 + (k >> 5)) * 4096 + (size_t)(swz_chunk(n & 127, (k & 31) >> 3) * 8 + (k & 7)); }
DI void seq_bounds(int t, int& s0, int& S) { if (t < T_PROMPT) { S = 16384; s0 = t & ~16383; } else { S = 4096; s0 = T_PROMPT + ((t - T_PROMPT) & ~4095); } }
DI void unpack8(u32x4 v, float* x) { x[0] = bflo(v.x); x[1] = bfhi(v.x); x[2] = bflo(v.y); x[3] = bfhi(v.y); x[4] = bflo(v.z); x[5] = bfhi(v.z); x[6] = bflo(v.w); x[7] = bfhi(v.w); }

DI void phase0(const Params& p, unsigned char* lds) {
  int tid = threadIdx.x; asm volatile("" : "+v"(tid)); const int nb = gridDim.x, bid = blockIdx.x, wid = tid >> 6, lane = tid & 63;
  float* tile = (float*)lds;
  bf16_t* win = (bf16_t*)(p.ws + WS_WIN);
  const int c = tid & 63, rg = tid >> 6;
  for (int task = bid; task < 2 * 50 * 16; task += nb) {
    const int l = task / 800, r = task % 800, nt = r / 16, kt = r % 16;
    const float* src = p.w_in + (size_t)l * 1024 * 3088; const float* nw = p.norm_w + l * 1024;
    const int n = nt * 64 + c;
    for (int i = 0; i < 16; ++i) { const int kk = rg * 16 + i, k = kt * 64 + kk; tile[kk * 65 + c] = (n < NV) ? src[(size_t)k * 3088 + refcol(n)] * nw[k] : 0.f; }
    __syncthreads();
    for (int i = 0; i < 16; ++i) { const int nn = rg * 16 + i; win[(size_t)l * 3200 * 1024 + tidxB(nt * 64 + nn, kt * 64 + c)] = f2bf(tile[c * 65 + nn]); }
    __syncthreads();
  }
  bf16_t* wout = (bf16_t*)(p.ws + WS_WOUT);
  for (int task = bid; task < 2 * 16 * 16; task += nb) {
    const int l = task / 256, r = task % 256, nt = r / 16, kt = r % 16;
    const float* src = p.w_out + (size_t)l * 1024 * 1024;
    for (int i = 0; i < 16; ++i) { const int kk = rg * 16 + i, k = kt * 64 + kk; tile[kk * 65 + c] = src[(size_t)k * 1024 + nt * 64 + c]; }
    __syncthreads();
    for (int i = 0; i < 16; ++i) { const int nn = rg * 16 + i; wout[(size_t)l * 1024 * 1024 + tidxB(nt * 64 + nn, kt * 64 + c)] = f2bf(tile[c * 65 + nn]); }
    __syncthreads();
  }
  const int gtid = bid * 256 + tid, gn = nb * 256;
  bf16_t* sguw = (bf16_t*)(p.ws + WS_SGUW);
  for (int i = gtid; i < 2 * 4 * 128 * 128; i += gn) sguw[i] = f2bf(p.sgu_w[i]);
  bf16_t* poolw = (bf16_t*)(p.ws + WS_POOLW);
  for (int i = gtid; i < 2 * 4 * 64 * 64; i += gn) { const int cc = i & 63, dd = (i >> 6) & 63, lg = i >> 12; poolw[i] = f2bf(p.pool_w[((size_t)lg * 64 + cc) * 64 + dd]); }
  f32x2* rope = (f32x2*)(p.ws + WS_ROPE);
  for (int i = gtid; i < 256 * 16; i += gn) {
    const int pidx = i >> 4, f = i & 15;
    const float inv = __builtin_amdgcn_exp2f(-(float)f * (13.287712379549449f / 16.f));
    const double rev = (double)pidx * (double)inv * 0.15915494309189535;
    const float fr = (float)(rev - floor(rev));
    rope[i] = (f32x2){__builtin_amdgcn_cosf(fr), __builtin_amdgcn_sinf(fr)};
  }
  float* ssq = (float*)(p.ws + WS_SSQ);
  for (int i = gtid; i < T_TOK; i += gn) ssq[T_TOK + i] = 0.f;
  if (gtid < 64) ((int*)(p.ws + WS_CNT))[gtid] = 0;
  bf16_t* xb = (bf16_t*)(p.ws + WS_OPS);
  for (int row = bid * 4 + wid; row < T_TOK; row += nb * 4) {
    const float* src = row < T_PROMPT ? p.x_prompt + (size_t)row * 1024 : p.x_sample + (size_t)(row - T_PROMPT) * 1024;
    float s = 0.f;
#pragma unroll
    for (int i = 0; i < 4; ++i) {
      const f32x4 v = *(const f32x4*)(src + i * 256 + lane * 4);
      s += v.x * v.x + v.y * v.y + v.z * v.z + v.w * v.w;
      *(u32x2*)(xb + tidxA(row, i * 256 + lane * 4)) = (u32x2){pk2(v.x, v.y), pk2(v.z, v.w)};
    }
#pragma unroll
    for (int o = 32; o >= 1; o >>= 1) s += __shfl_xor(s, o);
    if (lane == 0) ssq[row] = s;
  }
}

template <int MODE>
DI void gemm_phase(const Params& p, int layer, unsigned char* lds) {
  int tid = threadIdx.x; asm volatile("" : "+v"(tid)); const int wid = tid >> 6, lane = tid & 63, r = lane & 31, hh = lane >> 5;
  const int wm = wid >> 1, wn = wid & 1;
  bf16_t* proj = (bf16_t*)(p.ws + WS_PROJ);
  bf16_t* xb = (bf16_t*)(p.ws + WS_OPS);
  float* ssq = (float*)(p.ws + WS_SSQ);
  const bf16_t* A = MODE == 0 ? xb : proj;
  const bf16_t* Bt = MODE == 0 ? (const bf16_t*)(p.ws + WS_WIN) + (size_t)layer * 3200 * 1024 : (const bf16_t*)(p.ws + WS_WOUT) + (size_t)layer * 1024 * 1024;
  const int n_nt = MODE == 0 ? 25 : 8;
  const volatile unsigned* bst_ = (const volatile unsigned*)(lds + 73728 + 16);
  const unsigned nloc_ = bst_[0], nx_ = bst_[1];
  int start, stride, total, xid; const bool xmap = (nx_ == 8u && nloc_ > 0u);
  if (xmap) { start = (int)bst_[2]; stride = (int)nloc_; total = 24 * n_nt; xid = (int)(xb_xcc_id() & 7u); } else { start = blockIdx.x; stride = gridDim.x; total = 192 * n_nt; xid = 0; }
  for (int li = start; li < total; li += stride) {
    int mt, nt;
    if (xmap) { const int per_mg = 8 * n_nt, mg = li / per_mg, rem = li - mg * per_mg; nt = rem >> 3; mt = (mg * 8 + (rem & 7)) * 8 + xid; }
    else { mt = li / n_nt; nt = li % n_nt; }
    const int m0 = mt * 256, n0 = nt * 128;
    f32x16 acc[2][4];
#pragma unroll
    for (int a = 0; a < 2; ++a)
#pragma unroll
      for (int b = 0; b < 4; ++b)
#pragma unroll
        for (int i = 0; i < 16; ++i) acc[a][b][i] = 0.f;
    const int wu = __builtin_amdgcn_readfirstlane(wid);
    const int swr = (r >> 2) & 3;
    const int fo0 = ((0 + hh) ^ swr) * 8, fo1 = ((2 + hh) ^ swr) * 8;
#define G_DMA(kt, stg) do { \
    _Pragma("unroll") for (int i_ = 0; i_ < 4; ++i_) { const int q_ = wu + 4 * i_; \
      const bf16_t* src_; \
      if (MODE == 0) src_ = A + ((size_t)mt * 32 + (kt)) * 8192 + q_ * 512 + lane * 8; \
      else { const int P_ = q_ * 64 + lane, row_ = P_ >> 2, kc_ = (P_ & 3) ^ ((row_ >> 2) & 3); \
             const int ac_ = (((kt) >> 3) == 0 ? A_U : ((kt) >> 3) == 1 ? B_Z : ((kt) >> 3) == 2 ? C_Z : D_Z) + ((kt) & 7) * 32; \
             src_ = A + (size_t)(m0 + row_) * PP + ac_ + kc_ * 8; } \
      __builtin_amdgcn_global_load_lds((const unsigned*)src_, (LAS unsigned*)(lds + (stg) * 24576 + q_ * 1024), 16, 0, 0); } \
    _Pragma("unroll") for (int i_ = 0; i_ < 2; ++i_) { const int q_ = wu + 4 * i_; \
      __builtin_amdgcn_global_load_lds((const unsigned*)(Bt + ((size_t)nt * 32 + (kt)) * 4096 + q_ * 512 + lane * 8), (LAS unsigned*)(lds + (stg) * 24576 + 16384 + q_ * 1024), 16, 0, 0); } } while (0)
#define G_COMPUTE(stg) do { const bf16_t* a_ = (const bf16_t*)(lds + (stg) * 24576); const bf16_t* b_ = (const bf16_t*)(lds + (stg) * 24576 + 16384); \
    _Pragma("unroll") for (int ks = 0; ks < 2; ++ks) { bf16x8 af[4], bfr[2]; const int fo_ = ks ? fo1 : fo0; \
      _Pragma("unroll") for (int ni = 0; ni < 2; ++ni) bfr[ni] = *(const bf16x8*)(b_ + (wn * 64 + ni * 32 + r) * 32 + fo_); \
      _Pragma("unroll") for (int mi = 0; mi < 4; ++mi) af[mi] = *(const bf16x8*)(a_ + (wm * 128 + mi * 32 + r) * 32 + fo_); \
      _Pragma("unroll") for (int ni = 0; ni < 2; ++ni) _Pragma("unroll") for (int mi = 0; mi < 4; ++mi) acc[ni][mi] = mfma32(bfr[ni], af[mi], acc[ni][mi]); } } while (0)
    G_DMA(0, 0); G_DMA(1, 1);
    asm volatile("s_waitcnt vmcnt(6)" ::: "memory"); __builtin_amdgcn_s_barrier(); asm volatile("" ::: "memory");
    int s0_ = 0, s1_ = 1, s2_ = 2;
    for (int kt = 0; kt < 32; ++kt) {
      { const int kn_ = kt + 2 < 32 ? kt + 2 : 31; G_DMA(kn_, s2_); }
      G_COMPUTE(s0_);
      asm volatile("s_waitcnt vmcnt(6)" ::: "memory");
      asm volatile("s_waitcnt lgkmcnt(0)" ::: "memory"); __builtin_amdgcn_s_barrier(); asm volatile("" ::: "memory");
      const int t_ = s0_; s0_ = s1_; s1_ = s2_; s2_ = t_;
    }
    asm volatile("s_waitcnt vmcnt(0)" ::: "memory"); __builtin_amdgcn_s_barrier(); asm volatile("" ::: "memory");
#undef G_DMA
#undef G_COMPUTE
    {
      float* Ct = (float*)lds + wid * (64 * 68);
      const int rsub = lane >> 4, c4 = (lane & 15) * 4;
      const int colg = n0 + wn * 64 + c4;
#pragma unroll
      for (int rd = 0; rd < 2; ++rd) {
#pragma unroll
        for (int mi = 0; mi < 2; ++mi)
#pragma unroll
          for (int ni = 0; ni < 2; ++ni)
#pragma unroll
            for (int g = 0; g < 4; ++g)
              *(f32x4*)(Ct + (mi * 32 + r) * 68 + ni * 32 + 8 * g + 4 * hh) = (f32x4){acc[ni][2 * rd + mi][4 * g], acc[ni][2 * rd + mi][4 * g + 1], acc[ni][2 * rd + mi][4 * g + 2], acc[ni][2 * rd + mi][4 * g + 3]};
        asm volatile("s_waitcnt lgkmcnt(0)" ::: "memory");
#pragma unroll 4
        for (int j = 0; j < 16; ++j) {
          const int rl = 4 * j + rsub, row = m0 + wm * 128 + rd * 64 + rl;
          const f32x4 cv = *(const f32x4*)(Ct + rl * 68 + c4);
          if (MODE == 0) {
            const float rs = rsqrtf(ssq[layer * T_TOK + row] * (1.f / 1024.f) + EPSF);
            if (colg < NV) *(u32x2*)(proj + (size_t)row * PP + colg) = (u32x2){pk2(cv.x * rs, cv.y * rs), pk2(cv.z * rs, cv.w * rs)};
          } else {
            const float* xr = layer == 0 ? (row < T_PROMPT ? p.x_prompt + (size_t)row * 1024 : p.x_sample + (size_t)(row - T_PROMPT) * 1024) : p.out + (size_t)row * 1024;
            const f32x4 xv = *(const f32x4*)(xr + colg);
            const f32x4 o = xv + cv;
            *(f32x4*)(p.out + (size_t)row * 1024 + colg) = o;
            if (layer == 0) {
              *(u32x2*)(xb + tidxA(row, colg)) = (u32x2){pk2(o.x, o.y), pk2(o.z, o.w)};
              float sq = o.x * o.x + o.y * o.y + o.z * o.z + o.w * o.w;
              sq += __shfl_xor(sq, 1); sq += __shfl_xor(sq, 2); sq += __shfl_xor(sq, 4); sq += __shfl_xor(sq, 8);
              if ((lane & 15) == 0) __hip_atomic_fetch_add(ssq + T_TOK + row, sq, __ATOMIC_RELAXED, __HIP_MEMORY_SCOPE_AGENT);
            }
          }
        }
        asm volatile("s_waitcnt lgkmcnt(0)" ::: "memory");
      }
    }
    __syncthreads();
  }
}

template <int I>
DI void dn_solve_rows(float (&X)[64], const float* L) {
  if constexpr (I < 64) {
    float a0 = 0.f, a1 = 0.f;
#pragma unroll
    for (int j4 = 0; j4 < (I + 3) / 4; ++j4) {
      const f32x4 l = *(const f32x4*)(L + I * 68 + 4 * j4);
      if (4 * j4 < I) a0 += l.x * X[4 * j4];
      if (4 * j4 + 1 < I) a1 += l.y * X[4 * j4 + 1];
      if (4 * j4 + 2 < I) a0 += l.z * X[4 * j4 + 2];
      if (4 * j4 + 3 < I) a1 += l.w * X[4 * j4 + 3];
    }
    X[I] -= (a0 + a1);
    dn_solve_rows<I + 1>(X, L);
  }
}
template <int DIR, int ISW>
DI void dn_load_rhs(float (&X)[64], const float* k32, const float* v32, const float* gv, int lane) {
#pragma unroll
  for (int i = 0; i < 64; ++i) {
    const int c = DIR ? 63 - i : i;
    const float val = ISW ? k32[c * 64 + lane] * gv[256 + DIR * 64 + c] : v32[c * 64 + lane];
    X[i] = gv[DIR * 64 + c] * val;
  }
}
template <int DIR>
DI void dn_store_u(const float (&X)[64], unsigned char* ud, int lane) {
#pragma unroll
  for (int m = 0; m < 4; ++m)
#pragma unroll
    for (int qd = 0; qd < 4; ++qd) {
      const int c = 16 * m + 4 * qd;
      const float v0 = DIR ? X[63 - c] : X[c], v1 = DIR ? X[62 - c] : X[c + 1], v2 = DIR ? X[61 - c] : X[c + 2], v3 = DIR ? X[60 - c] : X[c + 3];
      *(u32x2*)(ud + ((((lane >> 4) * 4 + m) * 64 + qd * 16 + (lane & 15)) * 8)) = (u32x2){pk2(v0, v1), pk2(v2, v3)};
    }
}
template <int DIR>
DI void dn_store_w(const float (&X)[64], bf16_t* wd, int lane) {
#pragma unroll
  for (int i = 0; i < 64; ++i) { const int c = DIR ? 63 - i : i; wd[c * 68 + lane] = f2bf(-X[i]); }
}
DI void dn_prep(const Params& p, int layer, int cgi, int h, unsigned char* lds) {
  int tid = threadIdx.x; asm volatile("" : "+v"(tid)); const int wid = tid >> 6, lane = tid & 63;
  bf16_t* proj = (bf16_t*)(p.ws + WS_PROJ);
  const int t0 = cgi * 64; int s0, S; seq_bounds(t0, s0, S);
  float* k32 = (float*)lds; float* v32 = k32 + 4096; float* q32 = v32 + 4096;
  float* Lf = (float*)(lds + 32768); float* Lb = Lf + 64 * 68;
  bf16_t* qb = (bf16_t*)(lds + 49152); bf16_t* kb = qb + 64 * 72;
  bf16_t* Wt = (bf16_t*)lds;
  float* gv = (float*)(lds + 72192);
  unsigned char* ops = p.ws + WS_OPS + (size_t)(cgi * 4 + h) * OPS_STRIDE;
  bf16_t* stg = (bf16_t*)(lds + 32768);
  const bf16_t* grow = proj + (size_t)(t0 + (tid & 63)) * PP;
  const bf16_t gb0 = grow[B_BETA + h], gb1 = grow[B_BETA + 4 + h], ga0 = grow[B_ALPHA + h], ga1 = grow[B_ALPHA + 4 + h];
#pragma unroll
  for (int i = 0; i < 7; ++i) {
    const int ch = tid + 256 * i;
    if (ch < 1632) {
      const int tr = ch / 24, rem = ch - tr * 24, m = rem >> 3, c8 = rem & 7, tt = t0 - 2 + tr;
      u32x4 v = {0u, 0u, 0u, 0u};
      if (tt >= s0 && tt < s0 + S) v = *(const u32x4*)(proj + (size_t)tt * PP + B_Q + m * 256 + h * 64 + c8 * 8);
      *(u32x4*)(stg + tr * 200 + m * 64 + c8 * 8) = v;
    }
  }
  __syncthreads();
  {
    const int c = tid >> 2, sub = tid & 3;
    const float* cw = p.conv_w + (size_t)layer * 5 * 768;
    float res[3][16];
#pragma unroll
    for (int m = 0; m < 3; ++m) {
#pragma unroll
      for (int e = 0; e < 16; ++e) res[m][e] = 0.f;
      const int chb = m * 256 + h * 64 + sub * 16;
#pragma unroll
      for (int tap = 0; tap < 5; ++tap) {
        const bf16_t* src = stg + (c + tap) * 200 + m * 64 + sub * 16;
        const u32x4 v0 = *(const u32x4*)src, v1 = *(const u32x4*)(src + 8);
        float x[16]; unpack8(v0, x); unpack8(v1, x + 8);
        const float* w = cw + tap * 768 + chb;
#pragma unroll
        for (int e4 = 0; e4 < 4; ++e4) { const f32x4 wv = *(const f32x4*)(w + 4 * e4); res[m][4 * e4] += x[4 * e4] * wv.x; res[m][4 * e4 + 1] += x[4 * e4 + 1] * wv.y; res[m][4 * e4 + 2] += x[4 * e4 + 2] * wv.z; res[m][4 * e4 + 3] += x[4 * e4 + 3] * wv.w; }
      }
      float ss = 0.f;
#pragma unroll
      for (int e = 0; e < 16; ++e) { res[m][e] = silu(res[m][e]); ss += res[m][e] * res[m][e]; }
      if (m < 2) {
        ss += __shfl_xor(ss, 1); ss += __shfl_xor(ss, 2);
        float rn = rsqrtf(ss + EPSF); if (m == 0) rn *= 0.125f;
#pragma unroll
        for (int e = 0; e < 16; ++e) res[m][e] *= rn;
      }
    }
    __syncthreads();
#pragma unroll
    for (int m = 0; m < 3; ++m) {
      float* d32 = m == 0 ? q32 : (m == 1 ? k32 : v32);
#pragma unroll
      for (int e4 = 0; e4 < 4; ++e4) *(f32x4*)(d32 + c * 64 + sub * 16 + 4 * e4) = (f32x4){res[m][4 * e4], res[m][4 * e4 + 1], res[m][4 * e4 + 2], res[m][4 * e4 + 3]};
      if (m < 2) {
        bf16_t* db = m == 0 ? qb : kb;
        *(u32x4*)(db + c * 72 + sub * 16) = (u32x4){pk2(res[m][0], res[m][1]), pk2(res[m][2], res[m][3]), pk2(res[m][4], res[m][5]), pk2(res[m][6], res[m][7])};
        *(u32x4*)(db + c * 72 + sub * 16 + 8) = (u32x4){pk2(res[m][8], res[m][9]), pk2(res[m][10], res[m][11]), pk2(res[m][12], res[m][13]), pk2(res[m][14], res[m][15])};
      }
    }
  }
  if (tid < 64) {
    float beta[2], g[2];
#pragma unroll
    for (int d = 0; d < 2; ++d) {
      const float braw = bf2f(d ? gb1 : gb0), araw = bf2f(d ? ga1 : ga0);
      beta[d] = 1.f / (1.f + __expf(-braw));
      const float xx = araw + p.dt_bias[layer * 8 + d * 4 + h];
      const float sp = fmaxf(xx, 0.f) + log1pf(__expf(-fabsf(xx)));
      g[d] = -__expf(p.a_log[layer * 8 + d * 4 + h]) * sp;
    }
    float gf = g[0], gb = g[1];
#pragma unroll
    for (int o = 1; o < 64; o <<= 1) { const float vf = __shfl_up(gf, o), vb = __shfl_down(gb, o); if (lane >= o) gf += vf; if (lane + o < 64) gb += vb; }
    gv[tid] = beta[0]; gv[64 + tid] = beta[1]; gv[128 + tid] = gf; gv[192 + tid] = gb;
    const float egf = __expf(gf), egb = __expf(gb);
    gv[256 + tid] = egf; gv[320 + tid] = egb;
    const float glf = __shfl(gf, 63), glb = __shfl(gb, 0);
    float* vec = (float*)(ops + 65536);
    vec[tid] = egf; vec[64 + tid] = __expf(glf - gf); vec[128 + tid] = egb; vec[192 + tid] = __expf(glb - gb);
  }
  __syncthreads();
#pragma unroll
  for (int it = 0; it < 2; ++it) {
    const int sl = tid + it * 256, tl = sl >> 6, ln = sl & 63, mt = tl >> 1, s = tl & 1, quad = ln >> 4, r16 = ln & 15;
    const int rr = 16 * mt + r16, kb0 = 32 * s + 4 * quad;
    const f32x4 a = *(const f32x4*)(q32 + rr * 64 + kb0), b = *(const f32x4*)(q32 + rr * 64 + kb0 + 16);
    *(u32x4*)(ops + sl * 16) = (u32x4){pk2(a.x, a.y), pk2(a.z, a.w), pk2(b.x, b.y), pk2(b.z, b.w)};
    float e[8];
#pragma unroll
    for (int j = 0; j < 8; ++j) e[j] = k32[(kb0 + 16 * (j >> 2) + (j & 3)) * 64 + rr];
    *(u32x4*)(ops + 8192 + sl * 16) = (u32x4){pk2(e[0], e[1]), pk2(e[2], e[3]), pk2(e[4], e[5]), pk2(e[6], e[7])};
  }
  const int dir = wid >> 1, isW = wid & 1;
  f32x4 ckk[4], cqk[4];
#pragma unroll
  for (int m = 0; m < 4; ++m) { ckk[m] = (f32x4){0.f, 0.f, 0.f, 0.f}; cqk[m] = (f32x4){0.f, 0.f, 0.f, 0.f}; }
  const int n16 = lane & 15, quad = lane >> 4;
#pragma unroll
  for (int ks = 0; ks < 2; ++ks) {
    const bf16x8 bq = *(const bf16x8*)(qb + (16 * wid + n16) * 72 + 32 * ks + 8 * quad);
    const bf16x8 bk = *(const bf16x8*)(kb + (16 * wid + n16) * 72 + 32 * ks + 8 * quad);
#pragma unroll
    for (int m = 0; m < 4; ++m) {
      const bf16x8 ak = *(const bf16x8*)(kb + (16 * m + n16) * 72 + 32 * ks + 8 * quad);
      cqk[m] = mfma16(ak, bq, cqk[m]);
      ckk[m] = mfma16(ak, bk, ckk[m]);
    }
  }
  __syncthreads();
  {
    const int i = 16 * wid + n16;
    const float gfi = gv[128 + i], gbi = gv[192 + i], bfi = gv[i], bbi = gv[64 + i];
    f32x4 af[4], ab[4];
#pragma unroll
    for (int m = 0; m < 4; ++m) {
      const f32x4 gfj = *(const f32x4*)(gv + 128 + 16 * m + 4 * quad), gbj = *(const f32x4*)(gv + 192 + 16 * m + 4 * quad);
      f32x4 lf, lb;
#pragma unroll
      for (int jj = 0; jj < 4; ++jj) {
        const int jp = 16 * m + 4 * quad + jj;
        const float df = __expf(gfi - gfj[jj]), db = __expf(gbi - gbj[jj]);
        af[m][jj] = (i >= jp) ? cqk[m][jj] * df : 0.f;
        lf[jj] = (i > jp) ? bfi * ckk[m][jj] * df : 0.f;
        ab[m][jj] = (i <= jp) ? cqk[m][jj] * db : 0.f;
        lb[jj] = (i < jp) ? bbi * ckk[m][jj] * db : 0.f;
      }
      *(f32x4*)(Lf + i * 68 + 16 * m + 4 * quad) = lf;
      *(f32x4*)(Lb + (63 - i) * 68 + 60 - 16 * m - 4 * quad) = (f32x4){lb[3], lb[2], lb[1], lb[0]};
    }
#pragma unroll
    for (int s = 0; s < 2; ++s) {
      *(bf16x8*)(ops + 16384 + 8192 + ((wid * 2 + s) * 64 + lane) * 16) = pack8(af[2 * s], af[2 * s + 1]);
      *(bf16x8*)(ops + 16384 + 24576 + 8192 + ((wid * 2 + s) * 64 + lane) * 16) = pack8(ab[2 * s], ab[2 * s + 1]);
    }
  }
  float X[64];
  int cb = dir ? 63 : 0, cs = dir ? -1 : 1;
  unsigned soff = isW ? 0u : 16384u, goff = dir ? 64u : 0u;
  asm volatile("" : "+v"(cb), "+v"(cs), "+v"(soff), "+v"(goff));
  {
    const float* srcp = (const float*)(lds + soff) + lane;
    const float* gp = gv + goff;
#pragma unroll
    for (int i = 0; i < 64; ++i) {
      const int c = cb + cs * i;
      const float eg = gp[256 + c];
      X[i] = gp[c] * srcp[c * 64] * (isW ? eg : 1.f);
      if ((i & 15) == 15) asm volatile("" ::: "memory");
    }
  }
  __syncthreads();
  {
    unsigned loff = dir ? 32768u + 64u * 68u * 4u : 32768u;
    asm volatile("" : "+v"(loff));
    const float* L = (const float*)(lds + loff);
    dn_solve_rows<1>(X, L);
  }
  if (isW == 0) {
    unsigned char* ud = ops + 16384 + dir * 24576 + 16384;
#pragma unroll
    for (int m = 0; m < 4; ++m)
#pragma unroll
      for (int qd = 0; qd < 4; ++qd) {
        const int c = 16 * m + 4 * qd;
        const float v0 = dir ? X[63 - c] : X[c], v1 = dir ? X[62 - c] : X[c + 1], v2 = dir ? X[61 - c] : X[c + 2], v3 = dir ? X[60 - c] : X[c + 3];
        *(u32x2*)(ud + ((((lane >> 4) * 4 + m) * 64 + qd * 16 + (lane & 15)) * 8)) = (u32x2){pk2(v0, v1), pk2(v2, v3)};
      }
  } else {
    bf16_t* wd = Wt + dir * 64 * 68 + lane;
#pragma unroll
    for (int i = 0; i < 64; ++i) { const int c = cb + cs * i; wd[c * 68] = f2bf(-X[i]); }
  }
  __syncthreads();
#pragma unroll
  for (int it = 0; it < 4; ++it) {
    const int sl = tid + 256 * it, d = sl >> 9, s9 = sl & 511, tl = s9 >> 6, ln = s9 & 63, mt = tl >> 1, s = tl & 1, qd = ln >> 4, r16 = ln & 15;
    const bf16_t* src = Wt + d * 64 * 68 + (16 * mt + r16) * 68 + 32 * s + 4 * qd;
    const u32x2 lo = *(const u32x2*)src, hi = *(const u32x2*)(src + 16);
    *(u32x4*)(ops + 16384 + d * 24576 + s9 * 16) = (u32x4){lo.x, lo.y, hi.x, hi.y};
  }
  __syncthreads();
}

DI void dn_scan(const Params& p, int chain, unsigned char* lds) {
  int tid = threadIdx.x; asm volatile("" : "+v"(tid)); const int wid = tid >> 6, lane = tid & 63, n16 = lane & 15, quad = lane >> 4;
  int seqi, h, dir;
  if (chain < 16) { seqi = chain >> 3; h = (chain >> 1) & 3; dir = chain & 1; } else { const int cc = chain - 16; seqi = 2 + (cc >> 3); h = (cc >> 1) & 3; dir = cc & 1; }
  const int s0 = seqi < 2 ? seqi * 16384 : T_PROMPT + (seqi - 2) * 4096, S = seqi < 2 ? 16384 : 4096, nch = S / 64, cg0 = s0 / 64;
  bf16_t* proj = (bf16_t*)(p.ws + WS_PROJ);
  u32x4 st[11];
#define SC_PREFETCH(cgi_) do { const unsigned char* o_ = p.ws + WS_OPS + (size_t)((cgi_) * 4 + h) * OPS_STRIDE; \
    _Pragma("unroll") for (int i_ = 0; i_ < 4; ++i_) st[i_] = *(const u32x4*)(o_ + (tid + 256 * i_) * 16); \
    _Pragma("unroll") for (int i_ = 0; i_ < 6; ++i_) st[4 + i_] = *(const u32x4*)(o_ + 16384 + dir * 24576 + (tid + 256 * i_) * 16); \
    if (tid < 32) st[10] = *(const u32x4*)(o_ + 65536 + dir * 512 + tid * 16); } while (0)
  bf16_t* obuf = (bf16_t*)(lds + 41984);
  const int ocolb = (dir ? B_K : B_Q) + 64 * h;
#define SC_FLUSH(cprev_) do { _Pragma("unroll") for (int i_ = 0; i_ < 2; ++i_) { const int c_ = tid + 256 * i_, row_ = c_ >> 3, ch_ = c_ & 7; \
    *(u32x4*)(proj + (size_t)(s0 + (cprev_) * 64 + row_) * PP + ocolb + ch_ * 8) = *(const u32x4*)(obuf + row_ * 72 + ch_ * 8); } } while (0)
  f32x4 Sacc[4];
#pragma unroll
  for (int m = 0; m < 4; ++m) Sacc[m] = (f32x4){0.f, 0.f, 0.f, 0.f};
  SC_PREFETCH(cg0 + (dir ? nch - 1 : 0));
  for (int step = 0; step < nch; ++step) {
    const int ci = dir ? nch - 1 - step : step;
    __syncthreads();
    if (step > 0) SC_FLUSH(dir ? ci + 1 : ci - 1);
#pragma unroll
    for (int i = 0; i < 4; ++i) *(u32x4*)(lds + (tid + 256 * i) * 16) = st[i];
#pragma unroll
    for (int i = 0; i < 6; ++i) *(u32x4*)(lds + 16384 + (tid + 256 * i) * 16) = st[4 + i];
    if (tid < 32) *(u32x4*)(lds + 40960 + tid * 16) = st[10];
    __syncthreads();
    if (step + 1 < nch) SC_PREFETCH(cg0 + (dir ? ci - 1 : ci + 1));
    const float* eg = (const float*)(lds + 40960); const float* ekd = eg + 64;
    bf16x8 Sb[2];
#pragma unroll
    for (int s = 0; s < 2; ++s) Sb[s] = pack8(Sacc[2 * s], Sacc[2 * s + 1]);
    f32x4 vn[4], qs[4];
#pragma unroll
    for (int m = 0; m < 4; ++m) {
      const u32x2 u = *(const u32x2*)(lds + 32768 + ((wid * 4 + m) * 64 + lane) * 8);
      vn[m] = (f32x4){bflo(u.x), bfhi(u.x), bflo(u.y), bfhi(u.y)};
      qs[m] = (f32x4){0.f, 0.f, 0.f, 0.f};
#pragma unroll
      for (int s = 0; s < 2; ++s) {
        const bf16x8 aw = *(const bf16x8*)(lds + 16384 + ((m * 2 + s) * 64 + lane) * 16);
        vn[m] = mfma16(aw, Sb[s], vn[m]);
        const bf16x8 aq = *(const bf16x8*)(lds + ((m * 2 + s) * 64 + lane) * 16);
        qs[m] = mfma16(aq, Sb[s], qs[m]);
      }
    }
    f32x4 egv[4], v2[4];
#pragma unroll
    for (int m = 0; m < 4; ++m) { egv[m] = *(const f32x4*)(eg + 16 * m + 4 * quad); const f32x4 ek = *(const f32x4*)(ekd + 16 * m + 4 * quad); v2[m] = vn[m] * ek; }
    bf16x8 vb[2], vb2[2];
#pragma unroll
    for (int s = 0; s < 2; ++s) { vb[s] = pack8(vn[2 * s], vn[2 * s + 1]); vb2[s] = pack8(v2[2 * s], v2[2 * s + 1]); }
    const float egl = dir ? eg[0] : eg[63];
#pragma unroll
    for (int m = 0; m < 4; ++m) {
      f32x4 o = qs[m] * egv[m];
      f32x4 sn = Sacc[m] * egl;
#pragma unroll
      for (int s = 0; s < 2; ++s) {
        if (dir ? !(s == 0 && m >= 2) : !(s == 1 && m < 2)) {
          const bf16x8 aa = *(const bf16x8*)(lds + 24576 + ((m * 2 + s) * 64 + lane) * 16);
          o = mfma16(aa, vb[s], o);
        }
        const bf16x8 ak = *(const bf16x8*)(lds + 8192 + ((m * 2 + s) * 64 + lane) * 16);
        sn = mfma16(ak, vb2[s], sn);
      }
      Sacc[m] = sn;
#pragma unroll
      for (int j = 0; j < 4; ++j) obuf[(16 * m + 4 * quad + j) * 72 + 16 * wid + n16] = f2bf(o[j]);
    }
  }
#undef SC_PREFETCH
  __syncthreads();
  SC_FLUSH(dir ? 0 : nch - 1);
#undef SC_FLUSH
  __syncthreads();
}

DI void attn_prep(const Params& p, int layer, int tile) {
  int tid = threadIdx.x; asm volatile("" : "+v"(tid)); const int c = tid >> 2, sub = tid & 3, t = tile * 64 + c;
  int s0, S; seq_bounds(t, s0, S); const int pos = t - s0;
  const int pa = (sub >> 1) ? (pos & 63) : (pos >> 6);
  const f32x2* tab = (const f32x2*)(p.ws + WS_ROPE) + pa * 16;
  bf16_t* row = (bf16_t*)(p.ws + WS_PROJ) + (size_t)t * PP;
  f32x2 cs[16];
#pragma unroll
  for (int e = 0; e < 16; ++e) cs[e] = tab[e];
#pragma unroll
  for (int hd = 0; hd < 6; ++hd) {
    bf16_t* ptr = row + (hd < 4 ? C_Q + 64 * hd : C_K + 64 * (hd - 4)) + sub * 16;
    const float* w = (hd < 4 ? p.q_norm_w : p.k_norm_w) + layer * 64 + sub * 16;
    const u32x4 v0 = *(const u32x4*)ptr, v1 = *(const u32x4*)(ptr + 8);
    float x[16]; unpack8(v0, x); unpack8(v1, x + 8);
    float ss = 0.f;
#pragma unroll
    for (int e = 0; e < 16; ++e) ss += x[e] * x[e];
    ss += __shfl_xor(ss, 1); ss += __shfl_xor(ss, 2);
    const float rn = rsqrtf(ss * (1.f / 64.f) + EPSF);
    const float sc = hd < 4 ? 0.125f * 1.4426950408889634f : 1.f;
    float y[16];
#pragma unroll
    for (int e = 0; e < 16; ++e) {
      const float v = x[e] * rn * w[e];
      const float pr = __shfl_xor(v, 1);
      y[e] = ((sub & 1) ? v * cs[e].x + pr * cs[e].y : v * cs[e].x - pr * cs[e].y) * sc;
    }
    *(u32x4*)ptr = (u32x4){pk2(y[0], y[1]), pk2(y[2], y[3]), pk2(y[4], y[5]), pk2(y[6], y[7])};
    *(u32x4*)(ptr + 8) = (u32x4){pk2(y[8], y[9]), pk2(y[10], y[11]), pk2(y[12], y[13]), pk2(y[14], y[15])};
  }
}

DI void attn_unit(const Params& p, int unit, unsigned char* lds) {
  int tid = threadIdx.x; asm volatile("" : "+v"(tid)); const int wid = tid >> 6, lane = tid & 63, r = lane & 31, hh = lane >> 5;
  int seqi, kvh, kvc, qblk;
  if (unit < 2048) { qblk = unit & 127; const int g = unit >> 7; kvc = g & 3; kvh = (g >> 2) & 1; seqi = g >> 3; }
  else { const int u = unit - 2048; qblk = u & 31; const int g = u >> 5; kvh = g & 1; seqi = 2 + (g >> 1); kvc = 0; }
  const int s0 = seqi < 2 ? seqi * 16384 : T_PROMPT + (seqi - 2) * 4096;
  const int tq0 = s0 + qblk * 128 + 32 * wid, kt0 = s0 + kvc * 4096;
  bf16_t* proj = (bf16_t*)(p.ws + WS_PROJ);
  bf16_t* Ks = (bf16_t*)lds; bf16_t* Vs = Ks + 2 * 64 * 72;
  bf16x8 Qf[2][4];
#pragma unroll
  for (int g = 0; g < 2; ++g)
#pragma unroll
    for (int ks = 0; ks < 4; ++ks) Qf[g][ks] = *(const bf16x8*)(proj + (size_t)(tq0 + r) * PP + C_Q + 64 * (2 * kvh + g) + 16 * ks + 8 * hh);
  f32x16 O[2][2];
#pragma unroll
  for (int a = 0; a < 2; ++a)
#pragma unroll
    for (int b = 0; b < 2; ++b)
#pragma unroll
      for (int i = 0; i < 16; ++i) O[a][b][i] = 0.f;
  float lsum[2] = {0.f, 0.f};
  u32x4 rk[2], rv[2];
  const int skey = tid >> 3, sdc = (tid & 7) * 8;
#define AT_LOAD(tl_) do { _Pragma("unroll") for (int i_ = 0; i_ < 2; ++i_) { const bf16_t* b_ = proj + (size_t)(kt0 + (tl_) * 64 + skey + 32 * i_) * PP + 64 * kvh + sdc; \
    rk[i_] = *(const u32x4*)(b_ + C_K); rv[i_] = *(const u32x4*)(b_ + C_V); } } while (0)
#define AT_STORE(buf_) do { _Pragma("unroll") for (int i_ = 0; i_ < 2; ++i_) { *(u32x4*)(Ks + (buf_) * 64 * 72 + (skey + 32 * i_) * 72 + sdc) = rk[i_]; \
    *(u32x4*)(Vs + (buf_) * 64 * 72 + (skey + 32 * i_) * 72 + sdc) = rv[i_]; } } while (0)
  AT_LOAD(0); AT_STORE(0); __syncthreads();
  const int gi = (lane >> 4) & 1, qq = (lane & 15) >> 2, pp = lane & 3;
  const int troff = (4 * hh + qq) * 72 + 16 * gi + 4 * pp;
  for (int tl = 0; tl < 64; ++tl) {
    { const int tn_ = tl + 1 < 64 ? tl + 1 : 63; AT_LOAD(tn_); }
    asm volatile("" ::: "memory"); __builtin_amdgcn_sched_barrier(0);
    const bf16_t* k_ = Ks + (tl & 1) * 64 * 72; const bf16_t* v_ = Vs + (tl & 1) * 64 * 72;
#pragma unroll
    for (int kt = 0; kt < 2; ++kt) {
      f32x16 Sx[2];
      f32x16 zero16;
#pragma unroll
      for (int i = 0; i < 16; ++i) zero16[i] = 0.f;
#pragma unroll
      for (int ks = 0; ks < 4; ++ks) {
        const bf16x8 kf = *(const bf16x8*)(k_ + (32 * kt + r) * 72 + 16 * ks + 8 * hh);
#pragma unroll
        for (int g = 0; g < 2; ++g) Sx[g] = mfma32(kf, Qf[g][ks], ks == 0 ? zero16 : Sx[g]);
      }
      bf16x8 vf[2][2];
#pragma unroll
      for (int s = 0; s < 2; ++s)
#pragma unroll
        for (int dt = 0; dt < 2; ++dt) {
          const bf16_t* vb_ = v_ + (32 * kt + 16 * s) * 72 + 32 * dt + troff;
          const s16x4 lo = __builtin_amdgcn_ds_read_tr16_b64_v4i16((LAS s16x4*)(vb_));
          const s16x4 hi = __builtin_amdgcn_ds_read_tr16_b64_v4i16((LAS s16x4*)(vb_ + 8 * 72));
          vf[s][dt] = __builtin_shufflevector(lo, hi, 0, 1, 2, 3, 4, 5, 6, 7);
        }
#pragma unroll
      for (int g = 0; g < 2; ++g) {
        float pv[16];
#pragma unroll
        for (int i = 0; i < 16; ++i) { pv[i] = __builtin_amdgcn_exp2f(Sx[g][i]); lsum[g] += pv[i]; }
        bf16x8 Pb[2];
#pragma unroll
        for (int s = 0; s < 2; ++s) {
          const u32x4 w = {pk2(pv[8 * s], pv[8 * s + 1]), pk2(pv[8 * s + 2], pv[8 * s + 3]), pk2(pv[8 * s + 4], pv[8 * s + 5]), pk2(pv[8 * s + 6], pv[8 * s + 7])};
          Pb[s] = __builtin_bit_cast(bf16x8, w);
        }
#pragma unroll
        for (int s = 0; s < 2; ++s)
#pragma unroll
          for (int dt = 0; dt < 2; ++dt) O[dt][g] = mfma32(vf[s][dt], Pb[s], O[dt][g]);
      }
    }
    if (tl + 1 < 64) AT_STORE((tl + 1) & 1);
    __syncthreads();
  }
#undef AT_LOAD
#undef AT_STORE
  const int pcol = kvc == 0 ? A_V : (kvc == 1 ? A_Z : (kvc == 2 ? B_V : D_X));
  float* lbuf = (float*)(p.ws + WS_LBUF);
#pragma unroll
  for (int g = 0; g < 2; ++g) {
    const float l = lsum[g] + __shfl_xor(lsum[g], 32);
    const int hq = 2 * kvh + g;
    if (hh == 0) lbuf[((size_t)kvc * T_TOK + tq0 + r) * 4 + hq] = l;
    u32x2 own[2][4];
#pragma unroll
    for (int dt = 0; dt < 2; ++dt)
#pragma unroll
      for (int gq = 0; gq < 4; ++gq) own[dt][gq] = (u32x2){pk2(O[dt][g][4 * gq], O[dt][g][4 * gq + 1]), pk2(O[dt][g][4 * gq + 2], O[dt][g][4 * gq + 3])};
    u32x4 outv[4];
#pragma unroll
    for (int gq = 0; gq < 4; ++gq) {
      const u32x2 give = hh ? own[0][gq] : own[1][gq];
      u32x2 got; got.x = (unsigned)__shfl_xor((int)give.x, 32); got.y = (unsigned)__shfl_xor((int)give.y, 32);
      const u32x2 keep = hh ? own[1][gq] : own[0][gq];
      outv[gq] = hh ? (u32x4){got.x, got.y, keep.x, keep.y} : (u32x4){keep.x, keep.y, got.x, got.y};
    }
    bf16_t* dst = proj + (size_t)(tq0 + r) * PP + pcol + 64 * hq + 32 * hh;
#pragma unroll
    for (int gq = 0; gq < 4; ++gq) *(u32x4*)(dst + 8 * gq) = outv[gq];
  }
}

DI void sgu_task(const Params& p, int layer, int chunk, int h, unsigned char* lds) {
  int tid = threadIdx.x; asm volatile("" : "+v"(tid)); const int wid = tid >> 6, lane = tid & 63, r = lane & 31, hh = lane >> 5;
  const int t0 = chunk * 128;
  bf16_t* proj = (bf16_t*)(p.ws + WS_PROJ);
  bf16_t* vT = (bf16_t*)lds;
  {
    const int j = tid >> 1, half = tid & 1;
    const bf16_t* src = proj + (size_t)(t0 + j) * PP + A_V + 64 * h + half * 32;
    float x[32];
#pragma unroll
    for (int i = 0; i < 4; ++i) unpack8(*(const u32x4*)(src + 8 * i), x + 8 * i);
    float ss = 0.f;
#pragma unroll
    for (int e = 0; e < 32; ++e) ss += x[e] * x[e];
    ss += __shfl_xor(ss, 1);
    const float rn = rsqrtf(ss * (1.f / 64.f) + EPSF);
#pragma unroll
    for (int e = 0; e < 32; ++e) vT[(half * 32 + e) * 136 + j] = f2bf(x[e] * rn);
  }
  __syncthreads();
  const bf16_t* W = (const bf16_t*)(p.ws + WS_SGUW) + ((size_t)(layer * 4 + h) * 128 + 32 * wid + r) * 128;
  f32x16 acc[2];
#pragma unroll
  for (int a = 0; a < 2; ++a)
#pragma unroll
    for (int i = 0; i < 16; ++i) acc[a][i] = 0.f;
#pragma unroll
  for (int ks = 0; ks < 8; ++ks) {
    const bf16x8 a = *(const bf16x8*)(W + 16 * ks + 8 * hh);
#pragma unroll
    for (int nt = 0; nt < 2; ++nt) { const bf16x8 b = *(const bf16x8*)(vT + (32 * nt + r) * 136 + 16 * ks + 8 * hh); acc[nt] = mfma32(a, b, acc[nt]); }
  }
  const float* bias = p.sgu_b + (layer * 4 + h) * 128;
  __syncthreads();
  {
    float* Ct = (float*)lds + wid * (32 * 68);
#pragma unroll
    for (int nt = 0; nt < 2; ++nt)
#pragma unroll
      for (int i = 0; i < 16; ++i) Ct[crow(i, hh) * 68 + 32 * nt + r] = acc[nt][i] + bias[32 * wid + crow(i, hh)];
    asm volatile("s_waitcnt lgkmcnt(0)" ::: "memory");
    const int rsub = lane >> 4, c4 = (lane & 15) * 4;
#pragma unroll 4
    for (int j = 0; j < 8; ++j) {
      const int rl = 4 * j + rsub;
      const f32x4 cv = *(const f32x4*)(Ct + rl * 68 + c4);
      bf16_t* base = proj + (size_t)(t0 + 32 * wid + rl) * PP + 64 * h + c4;
      const u32x2 ur = *(const u32x2*)(base + A_U), zr = *(const u32x2*)(base + A_Z);
      *(u32x2*)(base + A_U) = (u32x2){pk2(bflo(ur.x) * cv.x * silu(bflo(zr.x)), bfhi(ur.x) * cv.y * silu(bfhi(zr.x))), pk2(bflo(ur.y) * cv.z * silu(bflo(zr.y)), bfhi(ur.y) * cv.w * silu(bfhi(zr.y)))};
    }
  }
  __syncthreads();
}

DI void pool_task(const Params& p, int layer, int tile, unsigned char* lds) {
  int tid = threadIdx.x; asm volatile("" : "+v"(tid)); const int wid = tid >> 6, lane = tid & 63, r = lane & 31, hh = lane >> 5;
  const int g = wid, half = 1 << g, t0 = tile * 64; int s0, S; seq_bounds(t0, s0, S);
  bf16_t* proj = (bf16_t*)(p.ws + WS_PROJ);
  bf16_t* xs = (bf16_t*)lds + g * 80 * 72;
  for (int i = 0; i < 10; ++i) {
    const int c = lane + 64 * i, rr = c >> 3, dc = (c & 7) * 8, t = t0 - 8 + rr;
    u32x4 v = {0u, 0u, 0u, 0u};
    if (t >= s0 && t < s0 + S) v = *(const u32x4*)(proj + (size_t)t * PP + D_X + 64 * g + dc);
    *(u32x4*)(xs + rr * 72 + dc) = v;
  }
  __syncthreads();
  f32x16 acc[2][2];
#pragma unroll
  for (int a = 0; a < 2; ++a)
#pragma unroll
    for (int b = 0; b < 2; ++b)
#pragma unroll
      for (int i = 0; i < 16; ++i) acc[a][b][i] = 0.f;
  const bf16_t* WT = (const bf16_t*)(p.ws + WS_POOLW) + (size_t)(layer * 4 + g) * 4096;
#pragma unroll
  for (int mt = 0; mt < 2; ++mt) {
    const int tl = 32 * mt + r, pos = t0 + tl - s0;
    const int lo = max(pos - half, 0), hi = min(pos + half, S);
    const float inv = 1.f / (float)(hi - lo);
#pragma unroll
    for (int ks = 0; ks < 4; ++ks) {
      float sum[8];
#pragma unroll
      for (int e = 0; e < 8; ++e) sum[e] = 0.f;
      for (int w = 0; w < 2 * half; ++w) {
        float x[8]; unpack8(*(const u32x4*)(xs + (tl + 8 - half + w) * 72 + 16 * ks + 8 * hh), x);
#pragma unroll
        for (int e = 0; e < 8; ++e) sum[e] += x[e];
      }
      float x0[8]; unpack8(*(const u32x4*)(xs + (tl + 8) * 72 + 16 * ks + 8 * hh), x0);
      const u32x4 w4 = {pk2(sum[0] * inv - x0[0], sum[1] * inv - x0[1]), pk2(sum[2] * inv - x0[2], sum[3] * inv - x0[3]), pk2(sum[4] * inv - x0[4], sum[5] * inv - x0[5]), pk2(sum[6] * inv - x0[6], sum[7] * inv - x0[7])};
      const bf16x8 a = __builtin_bit_cast(bf16x8, w4);
#pragma unroll
      for (int nt = 0; nt < 2; ++nt) { const bf16x8 b = *(const bf16x8*)(WT + (32 * nt + r) * 64 + 16 * ks + 8 * hh); acc[mt][nt] = mfma32(a, b, acc[mt][nt]); }
    }
  }
  __syncthreads();
  {
    float* Ct = (float*)lds + wid * (64 * 68);
#pragma unroll
    for (int nt = 0; nt < 2; ++nt) {
      const float psc = p.pool_scale[layer * 256 + 64 * g + 32 * nt + r];
#pragma unroll
      for (int mt = 0; mt < 2; ++mt)
#pragma unroll
        for (int i = 0; i < 16; ++i) Ct[(32 * mt + crow(i, hh)) * 68 + 32 * nt + r] = acc[mt][nt][i] * psc;
    }
    asm volatile("s_waitcnt lgkmcnt(0)" ::: "memory");
    const int rsub = lane >> 4, c4 = (lane & 15) * 4;
#pragma unroll 4
    for (int j = 0; j < 16; ++j) {
      const int rl = 4 * j + rsub;
      const f32x4 cv = *(const f32x4*)(Ct + rl * 68 + c4);
      bf16_t* ptr = proj + (size_t)(t0 + rl) * PP + D_Z + 64 * g + c4;
      const u32x2 zr = *(const u32x2*)ptr;
      *(u32x2*)ptr = (u32x2){pk2(cv.x * silu(bflo(zr.x)), cv.y * silu(bfhi(zr.x))), pk2(cv.z * silu(bflo(zr.y)), cv.w * silu(bfhi(zr.y)))};
    }
  }
  __syncthreads();
}

DI void combine_task(const Params& p, int layer, int tile) {
  int tid = threadIdx.x; asm volatile("" : "+v"(tid)); const int c = tid >> 2, sub = tid & 3, t = tile * 64 + c;
  bf16_t* row = (bf16_t*)(p.ws + WS_PROJ) + (size_t)t * PP;
  const float* dnw = p.dn_norm_w + layer * 64 + sub * 16;
  const float* lbuf = (const float*)(p.ws + WS_LBUF);
  const int nparts = t < T_PROMPT ? 4 : 1;
#pragma unroll
  for (int h = 0; h < 4; ++h) {
    const int col = 64 * h + sub * 16;
    {
      float a[16], b[16], z[16];
      unpack8(*(const u32x4*)(row + B_Q + col), a); unpack8(*(const u32x4*)(row + B_Q + col + 8), a + 8);
      unpack8(*(const u32x4*)(row + B_K + col), b); unpack8(*(const u32x4*)(row + B_K + col + 8), b + 8);
      unpack8(*(const u32x4*)(row + B_Z + col), z); unpack8(*(const u32x4*)(row + B_Z + col + 8), z + 8);
      float ss = 0.f;
#pragma unroll
      for (int e = 0; e < 16; ++e) { a[e] += b[e]; ss += a[e] * a[e]; }
      ss += __shfl_xor(ss, 1); ss += __shfl_xor(ss, 2);
      const float rn = rsqrtf(ss * (1.f / 64.f) + EPSF);
      float y[16];
#pragma unroll
      for (int e = 0; e < 16; ++e) y[e] = a[e] * rn * dnw[e] * silu(z[e]);
      *(u32x4*)(row + B_Z + col) = (u32x4){pk2(y[0], y[1]), pk2(y[2], y[3]), pk2(y[4], y[5]), pk2(y[6], y[7])};
      *(u32x4*)(row + B_Z + col + 8) = (u32x4){pk2(y[8], y[9]), pk2(y[10], y[11]), pk2(y[12], y[13]), pk2(y[14], y[15])};
    }
    {
      float o[16], z[16], l = 0.f;
#pragma unroll
      for (int e = 0; e < 16; ++e) o[e] = 0.f;
      for (int pi = 0; pi < nparts; ++pi) {
        const int pcol = pi == 0 ? A_V : (pi == 1 ? A_Z : (pi == 2 ? B_V : D_X));
        float a[16];
        unpack8(*(const u32x4*)(row + pcol + col), a); unpack8(*(const u32x4*)(row + pcol + col + 8), a + 8);
#pragma unroll
        for (int e = 0; e < 16; ++e) o[e] += a[e];
        l += lbuf[((size_t)pi * T_TOK + t) * 4 + h];
      }
      unpack8(*(const u32x4*)(row + C_Z + col), z); unpack8(*(const u32x4*)(row + C_Z + col + 8), z + 8);
      const float il = 1.f / l;
      float y[16];
#pragma unroll
      for (int e = 0; e < 16; ++e) y[e] = o[e] * il * silu(z[e]);
      *(u32x4*)(row + C_Z + col) = (u32x4){pk2(y[0], y[1]), pk2(y[2], y[3]), pk2(y[4], y[5]), pk2(y[6], y[7])};
      *(u32x4*)(row + C_Z + col + 8) = (u32x4){pk2(y[8], y[9]), pk2(y[10], y[11]), pk2(y[12], y[13]), pk2(y[14], y[15])};
    }
  }
}


#define XB_TMO      128
#define XB_XCNT(j)  (256  + 64 * (j))
#define XB_XSUB(j)  (1280 + 64 * (j))
#define XB_XGEN(j)  (2304 + 64 * (j))
#define XB_TOP      3328
#define XB_TOPGEN   3392
#define XCD_BAR_WORDS 3456
#define XB_SPIN_CAP (1u << 20)
DI unsigned xb_ld(unsigned* p) { return __hip_atomic_load(p, __ATOMIC_RELAXED, __HIP_MEMORY_SCOPE_AGENT); }
DI unsigned xb_add(unsigned* p, unsigned v) { return __hip_atomic_fetch_add(p, v, __ATOMIC_RELAXED, __HIP_MEMORY_SCOPE_AGENT); }
#define XB_SPIN(cond, bar) do { unsigned _sp = 0; while (cond) { __builtin_amdgcn_s_sleep(1); \
    if ((++_sp & 255u) == 0u) { if (xb_ld(&(bar)[XB_TMO])) break; if (_sp > XB_SPIN_CAP) { atomicAdd(&(bar)[XB_TMO], 1u); break; } } } } while (0)
struct XcdBarrier { unsigned* bar; unsigned x; volatile unsigned* st; };
DI XcdBarrier xcd_barrier_post(unsigned* bar, volatile unsigned* st) {
  XcdBarrier b; b.bar = bar; b.x = xb_xcc_id(); b.st = st;
  if (threadIdx.x == 0) st[2] = xb_add(&bar[XB_XCNT(b.x)], 1u);
  return b;
}
DI void xcd_barrier_complete(unsigned* bar, unsigned x, unsigned& nloc, unsigned& nx) {
  const unsigned G = gridDim.x;
  unsigned sum, cnt, mine, sp = 0u;
  for (;;) {
    sum = 0u; cnt = 0u; mine = 0u;
#pragma unroll
    for (unsigned j = 0; j < 16; ++j) { const unsigned c = xb_ld(&bar[XB_XCNT(j)]); sum += c; cnt += (c > 0u) ? 1u : 0u; mine = (j == x) ? c : mine; }
    if (sum == G) break;
    __builtin_amdgcn_s_sleep(1);
    if ((++sp & 255u) == 0u) { if (xb_ld(&bar[XB_TMO])) break; if (sp > XB_SPIN_CAP) { atomicAdd(&bar[XB_TMO], 1u); break; } }
  }
  nloc = mine > 0u ? mine : 1u; nx = cnt > 0u ? cnt : 1u;
}
DI void xcd_barrier(const XcdBarrier& b) {
  asm volatile("s_waitcnt vmcnt(0)" ::: "memory");
  __syncthreads();
  if (threadIdx.x == 0) {
    unsigned* bar = b.bar;
    __builtin_amdgcn_s_waitcnt(0);
    unsigned nloc = b.st[0], nx = b.st[1];
    if (nloc == 0u) { xcd_barrier_complete(bar, b.x, nloc, nx); b.st[0] = nloc; b.st[1] = nx; }
    const unsigned old = xb_add(&bar[XB_XSUB(b.x)], 1u);
    const unsigned gen = old / nloc;
    if (old + 1u == (gen + 1u) * nloc) {
      __builtin_amdgcn_fence(__ATOMIC_RELEASE, "agent");
      asm volatile("s_waitcnt vmcnt(0)" ::: "memory");
      const unsigned og = xb_add(&bar[XB_TOP], 1u);
      const unsigned tg = og / nx;
      if (og + 1u == (tg + 1u) * nx) xb_add(&bar[XB_TOPGEN], 1u);
      else XB_SPIN(xb_ld(&bar[XB_TOPGEN]) == tg, bar);
      __builtin_amdgcn_fence(__ATOMIC_ACQUIRE, "agent");
      xb_add(&bar[XB_XGEN(b.x)], 1u);
      asm volatile("s_waitcnt vmcnt(0)" ::: "memory");
    } else {
      XB_SPIN(xb_ld(&bar[XB_XGEN(b.x)]) == gen, bar);
      __builtin_amdgcn_fence(__ATOMIC_ACQUIRE, "agent");
      asm volatile("s_waitcnt vmcnt(0)" ::: "memory");
    }
  }
  __syncthreads();
}

#ifndef PMASK
#define PMASK 0xffff
#endif
__global__ void __launch_bounds__(256, 2) mega(Params p) {
  extern __shared__ __attribute__((aligned(16))) unsigned char lds[];
  const int tid = threadIdx.x;
  volatile unsigned* bst = (volatile unsigned*)(lds + 73728 + 16);
  XcdBarrier xb{};
  if (tid == 0) { bst[0] = 0u; bst[1] = 0u; bst[2] = 0u; bst[3] = 0u; }
  if (p.coop) { __syncthreads(); xb = xcd_barrier_post((unsigned*)(p.ws + WS_BAR), bst); }
  for (int ph = p.ph_lo; ph < p.ph_hi; ++ph) {
    if (ph == 0) { if (PMASK & 1) phase0(p, lds); }
    else {
      const int layer = (ph - 1) / 5, sub = (ph - 1) % 5;
      if (sub == 0) { if (PMASK & 2) gemm_phase<0>(p, layer, lds); }
      else if (sub == 1) {
        for (int task = blockIdx.x; task < 6144; task += gridDim.x) {
          if (task < 3072) { if (PMASK & 4) dn_prep(p, layer, task >> 2, task & 3, lds); }
          else if (task < 3840) { if (PMASK & 8) attn_prep(p, layer, task - 3072); }
          else if (task < 5376) { if (PMASK & 16) sgu_task(p, layer, (task - 3840) >> 2, (task - 3840) & 3, lds); }
          else { if (PMASK & 32) pool_task(p, layer, task - 5376, lds); }
        }
      } else if (sub == 2) {
        if (PMASK & 64) for (int chain = blockIdx.x; chain < 48; chain += gridDim.x) dn_scan(p, chain, lds);
        int* cnt = (int*)(p.ws + WS_CNT) + layer;
        int* su = (int*)(lds + 73728);
        for (;;) {
          __syncthreads();
          if (tid == 0) *su = atomicAdd(cnt, 1);
          __syncthreads();
          const int u = *su;
          if (u >= N_ATT_UNITS) break;
          if (PMASK & 128) attn_unit(p, u, lds);
        }
      } else if (sub == 3) {
        if (PMASK & 256) for (int task = blockIdx.x; task < 768; task += gridDim.x) combine_task(p, layer, task);
      } else { if (PMASK & 512) gemm_phase<1>(p, layer, lds); }
    }
    if (p.coop && ph + 1 < p.ph_hi) { if (p.coop > 1) cg::this_grid().sync(); else xcd_barrier(xb); }
  }
}

extern "C" void kernel_launch(void* const* d_in, const int* in_sizes, int n_in, void* d_out, int out_size, void* d_ws, size_t ws_size, hipStream_t stream) {
  static int grid = 0, coop_ok = 1;
  if (grid == 0) {
    if (n_in != 15 || ws_size < WS_END || out_size != T_TOK * 1024) { fprintf(stderr, "kernel_launch: unexpected shapes (n_in %d, ws %zu need %zu, out %d)\n", n_in, ws_size, (size_t)WS_END, out_size); grid = -1; return; }
    int dev = 0, cus = 0, per_cu = 0;
    hipGetDevice(&dev);
    hipDeviceGetAttribute(&cus, hipDeviceAttributeMultiprocessorCount, dev);
    if (hipFuncSetAttribute((const void*)mega, hipFuncAttributeMaxDynamicSharedMemorySize, LDS_BYTES) != hipSuccess) { fprintf(stderr, "kernel_launch: hipFuncSetAttribute failed\n"); grid = -1; return; }
    if (hipOccupancyMaxActiveBlocksPerMultiprocessor(&per_cu, (const void*)mega, 256, LDS_BYTES) != hipSuccess || per_cu < 1) { fprintf(stderr, "kernel_launch: occupancy query failed (%d)\n", per_cu); per_cu = 1; (void)hipGetLastError(); }
    if (per_cu > 2) per_cu = 2;
    grid = cus * per_cu;
    fprintf(stderr, "kernel_launch: grid %d (%d CUs x %d)\n", grid, cus, per_cu);
  }
  if (grid < 0) return;
  Params p{};
  p.x_prompt = (const float*)d_in[0]; p.x_sample = (const float*)d_in[1]; p.norm_w = (const float*)d_in[2]; p.w_in = (const float*)d_in[3];
  p.sgu_w = (const float*)d_in[4]; p.sgu_b = (const float*)d_in[5]; p.conv_w = (const float*)d_in[6]; p.a_log = (const float*)d_in[7];
  p.dt_bias = (const float*)d_in[8]; p.dn_norm_w = (const float*)d_in[9]; p.q_norm_w = (const float*)d_in[10]; p.k_norm_w = (const float*)d_in[11];
  p.pool_w = (const float*)d_in[12]; p.pool_scale = (const float*)d_in[13]; p.w_out = (const float*)d_in[14];
  p.out = (float*)d_out; p.ws = (unsigned char*)d_ws;
  if (coop_ok) {
    p.ph_lo = 0; p.ph_hi = 11; p.coop = 1;
    if (hipMemsetAsync((char*)d_ws + WS_BAR, 0, 16384, stream) != hipSuccess) { fprintf(stderr, "kernel_launch: memset of barrier words failed\n"); return; }
    void* args[] = {&p};
    const hipError_t e = hipLaunchCooperativeKernel((const void*)mega, dim3(grid), dim3(256), args, LDS_BYTES, stream);
    if (e == hipSuccess) return;
    fprintf(stderr, "kernel_launch: cooperative launch failed: %s (grid %d); falling back to one launch per phase\n", hipGetErrorString(e), grid);
    (void)hipGetLastError();
    coop_ok = 0;
  }
  for (int ph = 0; ph < 11; ++ph) {
    p.ph_lo = ph; p.ph_hi = ph + 1; p.coop = 0;
    hipLaunchKernelGGL(mega, dim3(grid), dim3(256), LDS_BYTES, stream, p);
  }
}
```

```cpp
#include <hip/hip_runtime.h>
#include <hip/hip_cooperative_groups.h>
#include <cstdio>
#include <cstdint>
namespace cg = cooperative_groups;

#define DI __device__ __forceinline__
#define LAS __attribute__((address_space(3)))

typedef unsigned short bf16_t;
typedef short bf16x8 __attribute__((ext_vector_type(8)));
typedef short s16x4 __attribute__((ext_vector_type(4)));
typedef float f32x2 __attribute__((ext_vector_type(2)));
typedef float f32x4 __attribute__((ext_vector_type(4)));
typedef float f32x16 __attribute__((ext_vector_type(16)));
typedef unsigned u32x2 __attribute__((ext_vector_type(2)));
typedef unsigned u32x4 __attribute__((ext_vector_type(4)));
typedef __bf16 bfv2 __attribute__((ext_vector_type(2)));

constexpr int T_TOK = 49152, T_PROMPT = 32768;
constexpr int PP = 3136;
constexpr int NV = 3088;
constexpr int A_U = 0, A_V = 256, A_Z = 512, B_Q = 768, B_K = 1024, B_V = 1280, B_Z = 1536,
              C_Q = 1792, C_K = 2048, C_V = 2176, C_Z = 2304, D_X = 2560, D_Z = 2816, B_BETA = 3072, B_ALPHA = 3080;
__host__ __device__ constexpr int refcol(int n) { return n < 1792 ? n : (n < 3072 ? n + 16 : 1792 + (n - 3072)); }
constexpr float EPSF = 1e-6f;

constexpr size_t WS_WIN = 0;
constexpr size_t WS_WOUT = 13107200;
constexpr size_t WS_SGUW = 17301504;
constexpr size_t WS_POOLW = 17563648;
constexpr size_t WS_ROPE = 17629184;
constexpr size_t WS_SSQ = 17661952;
constexpr size_t WS_LBUF = 18055168;
constexpr size_t WS_CNT = 21200896;
constexpr size_t WS_PROJ = 21201152;
constexpr size_t WS_OPS = WS_PROJ + (size_t)T_TOK * PP * 2;
constexpr size_t OPS_STRIDE = 66560;
constexpr size_t WS_BAR = WS_OPS + 3072 * OPS_STRIDE;
constexpr size_t WS_END = WS_BAR + 16384;
constexpr int LDS_BYTES = 73728 + 64;
constexpr int N_ATT_UNITS = 2304;

struct Params {
  const float* x_prompt; const float* x_sample; const float* norm_w; const float* w_in; const float* sgu_w; const float* sgu_b;
  const float* conv_w; const float* a_log; const float* dt_bias; const float* dn_norm_w; const float* q_norm_w; const float* k_norm_w;
  const float* pool_w; const float* pool_scale; const float* w_out;
  float* out; unsigned char* ws;
  int ph_lo, ph_hi, coop, pad;
};

DI float bf2f(bf16_t v) { return __uint_as_float((unsigned)v << 16); }
DI float bflo(unsigned u) { return __uint_as_float(u << 16); }
DI float bfhi(unsigned u) { return __uint_as_float(u & 0xffff0000u); }
DI unsigned pk2(float lo, float hi) { f32x2 v = {lo, hi}; bfv2 b = __builtin_convertvector(v, bfv2); return __builtin_bit_cast(unsigned, b); }
DI bf16_t f2bf(float x) { return (bf16_t)(pk2(x, 0.f) & 0xffffu); }
DI bf16x8 pack8(f32x4 a, f32x4 b) { u32x4 w = {pk2(a.x, a.y), pk2(a.z, a.w), pk2(b.x, b.y), pk2(b.z, b.w)}; return __builtin_bit_cast(bf16x8, w); }
DI float silu(float x) { return x * __builtin_amdgcn_rcpf(1.f + __expf(-x)); }
DI unsigned xb_xcc_id() { return (unsigned)__builtin_amdgcn_s_getreg((3 << 11) | 20) & 0xFu; }
DI int crow(int i, int h) { return (i & 3) + 8 * (i >> 2) + 4 * h; }
DI f32x16 mfma32(bf16x8 a, bf16x8 b, f32x16 c) { return __builtin_amdgcn_mfma_f32_32x32x16_bf16(a, b, c, 0, 0, 0); }
DI f32x4 mfma16(bf16x8 a, bf16x8 b, f32x4 c) { return __builtin_amdgcn_mfma_f32_16x16x32_bf16(a, b, c, 0, 0, 0); }
DI int swz_chunk(int row, int kc) { return row * 4 + (kc ^ ((row >> 2) & 3)); }
DI size_t tidxA(int row, int k) { return ((size_t)(row >> 8) * 32 + (k >> 5)) * 8192 + (size_t)(swz_chunk(row & 255, (k & 31) >> 3) * 8 + (k & 7)); }
DI size_t tidxB(int n, int k) { return ((size_t)(n >> 7) * 32 + (k >> 5)) * 4096 + (size_t)(swz_chunk(n & 127, (k & 31) >> 3) * 8 + (k & 7)); }
DI void seq_bounds(int t, int& s0, int& S) { if (t < T_PROMPT) { S = 16384; s0 = t & ~16383; } else { S = 4096; s0 = T_PROMPT + ((t - T_PROMPT) & ~4095); } }
DI void unpack8(u32x4 v, float* x) { x[0] = bflo(v.x); x[1] = bfhi(v.x); x[2] = bflo(v.y); x[3] = bfhi(v.y); x[4] = bflo(v.z); x[5] = bfhi(v.z); x[6] = bflo(v.w); x[7] = bfhi(v.w); }

DI void phase0(const Params& p, unsigned char* lds) {
  int tid = threadIdx.x; asm volatile("" : "+v"(tid)); const int nb = gridDim.x, bid = blockIdx.x, wid = tid >> 6, lane = tid & 63;
  float* tile = (float*)lds;
  bf16_t* win = (bf16_t*)(p.ws + WS_WIN);
  const int c = tid & 63, rg = tid >> 6;
  for (int task = bid; task < 2 * 50 * 16; task += nb) {
    const int l = task / 800, r = task % 800, nt = r / 16, kt = r % 16;
    const float* src = p.w_in + (size_t)l * 1024 * 3088; const float* nw = p.norm_w + l * 1024;
    const int n = nt * 64 + c;
    for (int i = 0; i < 16; ++i) { const int kk = rg * 16 + i, k = kt * 64 + kk; tile[kk * 65 + c] = (n < NV) ? src[(size_t)k * 3088 + refcol(n)] * nw[k] : 0.f; }
    __syncthreads();
    for (int i = 0; i < 16; ++i) { const int nn = rg * 16 + i; win[(size_t)l * 3200 * 1024 + tidxB(nt * 64 + nn, kt * 64 + c)] = f2bf(tile[c * 65 + nn]); }
    __syncthreads();
  }
  bf16_t* wout = (bf16_t*)(p.ws + WS_WOUT);
  for (int task = bid; task < 2 * 16 * 16; task += nb) {
    const int l = task / 256, r = task % 256, nt = r / 16, kt = r % 16;
    const float* src = p.w_out + (size_t)l * 1024 * 1024;
    for (int i = 0; i < 16; ++i) { const int kk = rg * 16 + i, k = kt * 64 + kk; tile[kk * 65 + c] = src[(size_t)k * 1024 + nt * 64 + c]; }
    __syncthreads();
    for (int i = 0; i < 16; ++i) { const int nn = rg * 16 + i; wout[(size_t)l * 1024 * 1024 + tidxB(nt * 64 + nn, kt * 64 + c)] = f2bf(tile[c * 65 + nn]); }
    __syncthreads();
  }
  const int gtid = bid * 256 + tid, gn = nb * 256;
  bf16_t* sguw = (bf16_t*)(p.ws + WS_SGUW);
  for (int i = gtid; i < 2 * 4 * 128 * 128; i += gn) sguw[i] = f2bf(p.sgu_w[i]);
  bf16_t* poolw = (bf16_t*)(p.ws + WS_POOLW);
  for (int i = gtid; i < 2 * 4 * 64 * 64; i += gn) { const int cc = i & 63, dd = (i >> 6) & 63, lg = i >> 12; poolw[i] = f2bf(p.pool_w[((size_t)lg * 64 + cc) * 64 + dd]); }
  f32x2* rope = (f32x2*)(p.ws + WS_ROPE);
  for (int i = gtid; i < 256 * 16; i += gn) {
    const int pidx = i >> 4, f = i & 15;
    const float inv = __builtin_amdgcn_exp2f(-(float)f * (13.287712379549449f / 16.f));
    const double rev = (double)pidx * (double)inv * 0.15915494309189535;
    const float fr = (float)(rev - floor(rev));
    rope[i] = (f32x2){__builtin_amdgcn_cosf(fr), __builtin_amdgcn_sinf(fr)};
  }
  float* ssq = (float*)(p.ws + WS_SSQ);
  for (int i = gtid; i < T_TOK; i += gn) ssq[T_TOK + i] = 0.f;
  if (gtid < 64) ((int*)(p.ws + WS_CNT))[gtid] = 0;
  bf16_t* xb = (bf16_t*)(p.ws + WS_OPS);
  for (int row = bid * 4 + wid; row < T_TOK; row += nb * 4) {
    const float* src = row < T_PROMPT ? p.x_prompt + (size_t)row * 1024 : p.x_sample + (size_t)(row - T_PROMPT) * 1024;
    float s = 0.f;
#pragma unroll
    for (int i = 0; i < 4; ++i) {
      const f32x4 v = *(const f32x4*)(src + i * 256 + lane * 4);
      s += v.x * v.x + v.y * v.y + v.z * v.z + v.w * v.w;
      *(u32x2*)(xb + tidxA(row, i * 256 + lane * 4)) = (u32x2){pk2(v.x, v.y), pk2(v.z, v.w)};
    }
#pragma unroll
    for (int o = 32; o >= 1; o >>= 1) s += __shfl_xor(s, o);
    if (lane == 0) ssq[row] = s;
  }
}

template <int MODE>
DI void gemm_phase(const Params& p, int layer, unsigned char* lds) {
  int tid = threadIdx.x; asm volatile("" : "+v"(tid)); const int wid = tid >> 6, lane = tid & 63, r = lane & 31, hh = lane >> 5;
  const int wm = wid >> 1, wn = wid & 1;
  bf16_t* proj = (bf16_t*)(p.ws + WS_PROJ);
  bf16_t* xb = (bf16_t*)(p.ws + WS_OPS);
  float* ssq = (float*)(p.ws + WS_SSQ);
  const bf16_t* A = MODE == 0 ? xb : proj;
  const bf16_t* Bt = MODE == 0 ? (const bf16_t*)(p.ws + WS_WIN) + (size_t)layer * 3200 * 1024 : (const bf16_t*)(p.ws + WS_WOUT) + (size_t)layer * 1024 * 1024;
  const int n_nt = MODE == 0 ? 25 : 8;
  const volatile unsigned* bst_ = (const volatile unsigned*)(lds + 73728 + 16);
  const unsigned nloc_ = bst_[0], nx_ = bst_[1];
  int start, stride, total, xid; const bool xmap = (nx_ == 8u && nloc_ > 0u);
  if (xmap) { start = (int)bst_[2]; stride = (int)nloc_; total = 24 * n_nt; xid = (int)(xb_xcc_id() & 7u); } else { start = blockIdx.x; stride = gridDim.x; total = 192 * n_nt; xid = 0; }
  for (int li = start; li < total; li += stride) {
    int mt, nt;
    if (xmap) { const int per_mg = 8 * n_nt, mg = li / per_mg, rem = li - mg * per_mg; nt = rem >> 3; mt = (mg * 8 + (rem & 7)) * 8 + xid; }
    else { mt = li / n_nt; nt = li % n_nt; }
    const int m0 = mt * 256, n0 = nt * 128;
    f32x16 acc[2][4];
#pragma unroll
    for (int a = 0; a < 2; ++a)
#pragma unroll
      for (int b = 0; b < 4; ++b)
#pragma unroll
        for (int i = 0; i < 16; ++i) acc[a][b][i] = 0.f;
    const int wu = __builtin_amdgcn_readfirstlane(wid);
    const int swr = (r >> 2) & 3;
    const int fo0 = ((0 + hh) ^ swr) * 8, fo1 = ((2 + hh) ^ swr) * 8;
#define G_DMA(kt, stg) do { \
    _Pragma("unroll") for (int i_ = 0; i_ < 4; ++i_) { const int q_ = wu + 4 * i_; \
      const bf16_t* src_; \
      if (MODE == 0) src_ = A + ((size_t)mt * 32 + (kt)) * 8192 + q_ * 512 + lane * 8; \
      else { const int P_ = q_ * 64 + lane, row_ = P_ >> 2, kc_ = (P_ & 3) ^ ((row_ >> 2) & 3); \
             const int ac_ = (((kt) >> 3) == 0 ? A_U : ((kt) >> 3) == 1 ? B_Z : ((kt) >> 3) == 2 ? C_Z : D_Z) + ((kt) & 7) * 32; \
             src_ = A + (size_t)(m0 + row_) * PP + ac_ + kc_ * 8; } \
      __builtin_amdgcn_global_load_lds((const unsigned*)src_, (LAS unsigned*)(lds + (stg) * 24576 + q_ * 1024), 16, 0, 0); } \
    _Pragma("unroll") for (int i_ = 0; i_ < 2; ++i_) { const int q_ = wu + 4 * i_; \
      __builtin_amdgcn_global_load_lds((const unsigned*)(Bt + ((size_t)nt * 32 + (kt)) * 4096 + q_ * 512 + lane * 8), (LAS unsigned*)(lds + (stg) * 24576 + 16384 + q_ * 1024), 16, 0, 0); } } while (0)
#define G_COMPUTE(stg) do { const bf16_t* a_ = (const bf16_t*)(lds + (stg) * 24576); const bf16_t* b_ = (const bf16_t*)(lds + (stg) * 24576 + 16384); \
    _Pragma("unroll") for (int ks = 0; ks < 2; ++ks) { bf16x8 af[4], bfr[2]; const int fo_ = ks ? fo1 : fo0; \
      _Pragma("unroll") for (int ni = 0; ni < 2; ++ni) bfr[ni] = *(const bf16x8*)(b_ + (wn * 64 + ni * 32 + r) * 32 + fo_); \
      _Pragma("unroll") for (int mi = 0; mi < 4; ++mi) af[mi] = *(const bf16x8*)(a_ + (wm * 128 + mi * 32 + r) * 32 + fo_); \
      _Pragma("unroll") for (int ni = 0; ni < 2; ++ni) _Pragma("unroll") for (int mi = 0; mi < 4; ++mi) acc[ni][mi] = mfma32(bfr[ni], af[mi], acc[ni][mi]); } } while (0)
    G_DMA(0, 0); G_DMA(1, 1);
    asm volatile("s_waitcnt vmcnt(6)" ::: "memory"); __builtin_amdgcn_s_barrier(); asm volatile("" ::: "memory");
    int s0_ = 0, s1_ = 1, s2_ = 2;
    for (int kt = 0; kt < 32; ++kt) {
      { const int kn_ = kt + 2 < 32 ? kt + 2 : 31; G_DMA(kn_, s2_); }
      G_COMPUTE(s0_);
      asm volatile("s_waitcnt vmcnt(6)" ::: "memory");
      asm volatile("s_waitcnt lgkmcnt(0)" ::: "memory"); __builtin_amdgcn_s_barrier(); asm volatile("" ::: "memory");
      const int t_ = s0_; s0_ = s1_; s1_ = s2_; s2_ = t_;
    }
    asm volatile("s_waitcnt vmcnt(0)" ::: "memory"); __builtin_amdgcn_s_barrier(); asm volatile("" ::: "memory");
#undef G_DMA
#undef G_COMPUTE
    {
      float* Ct = (float*)lds + wid * (64 * 68);
      const int rsub = lane >> 4, c4 = (lane & 15) * 4;
      const int colg = n0 + wn * 64 + c4;
#pragma unroll
      for (int rd = 0; rd < 2; ++rd) {
#pragma unroll
        for (int mi = 0; mi < 2; ++mi)
#pragma unroll
          for (int ni = 0; ni < 2; ++ni)
#pragma unroll
            for (int g = 0; g < 4; ++g)
              *(f32x4*)(Ct + (mi * 32 + r) * 68 + ni * 32 + 8 * g + 4 * hh) = (f32x4){acc[ni][2 * rd + mi][4 * g], acc[ni][2 * rd + mi][4 * g + 1], acc[ni][2 * rd + mi][4 * g + 2], acc[ni][2 * rd + mi][4 * g + 3]};
        asm volatile("s_waitcnt lgkmcnt(0)" ::: "memory");
#pragma unroll 4
        for (int j = 0; j < 16; ++j) {
          const int rl = 4 * j + rsub, row = m0 + wm * 128 + rd * 64 + rl;
          const f32x4 cv = *(const f32x4*)(Ct + rl * 68 + c4);
          if (MODE == 0) {
            const float rs = rsqrtf(ssq[layer * T_TOK + row] * (1.f / 1024.f) + EPSF);
            if (colg < NV) *(u32x2*)(proj + (size_t)row * PP + colg) = (u32x2){pk2(cv.x * rs, cv.y * rs), pk2(cv.z * rs, cv.w * rs)};
          } else {
            const float* xr = layer == 0 ? (row < T_PROMPT ? p.x_prompt + (size_t)row * 1024 : p.x_sample + (size_t)(row - T_PROMPT) * 1024) : p.out + (size_t)row * 1024;
            const f32x4 xv = *(const f32x4*)(xr + colg);
            const f32x4 o = xv + cv;
            *(f32x4*)(p.out + (size_t)row * 1024 + colg) = o;
            if (layer == 0) {
              *(u32x2*)(xb + tidxA(row, colg)) = (u32x2){pk2(o.x, o.y), pk2(o.z, o.w)};
              float sq = o.x * o.x + o.y * o.y + o.z * o.z + o.w * o.w;
              sq += __shfl_xor(sq, 1); sq += __shfl_xor(sq, 2); sq += __shfl_xor(sq, 4); sq += __shfl_xor(sq, 8);
              if ((lane & 15) == 0) __hip_atomic_fetch_add(ssq + T_TOK + row, sq, __ATOMIC_RELAXED, __HIP_MEMORY_SCOPE_AGENT);
            }
          }
        }
        asm volatile("s_waitcnt lgkmcnt(0)" ::: "memory");
      }
    }
    __syncthreads();
  }
}

template <int I>
DI void dn_solve_rows(float (&X)[64], const float* L) {
  if constexpr (I < 64) {
    float a0 = 0.f, a1 = 0.f;
#pragma unroll
    for (int j4 = 0; j4 < (I + 3) / 4; ++j4) {
      const f32x4 l = *(const f32x4*)(L + I * 68 + 4 * j4);
      if (4 * j4 < I) a0 += l.x * X[4 * j4];
      if (4 * j4 + 1 < I) a1 += l.y * X[4 * j4 + 1];
      if (4 * j4 + 2 < I) a0 += l.z * X[4 * j4 + 2];
      if (4 * j4 + 3 < I) a1 += l.w * X[4 * j4 + 3];
    }
    X[I] -= (a0 + a1);
    dn_solve_rows<I + 1>(X, L);
  }
}
template <int DIR, int ISW>
DI void dn_load_rhs(float (&X)[64], const float* k32, const float* v32, const float* gv, int lane) {
#pragma unroll
  for (int i = 0; i < 64; ++i) {
    const int c = DIR ? 63 - i : i;
    const float val = ISW ? k32[c * 64 + lane] * gv[256 + DIR * 64 + c] : v32[c * 64 + lane];
    X[i] = gv[DIR * 64 + c] * val;
  }
}
template <int DIR>
DI void dn_store_u(const float (&X)[64], unsigned char* ud, int lane) {
#pragma unroll
  for (int m = 0; m < 4; ++m)
#pragma unroll
    for (int qd = 0; qd < 4; ++qd) {
      const int c = 16 * m + 4 * qd;
      const float v0 = DIR ? X[63 - c] : X[c], v1 = DIR ? X[62 - c] : X[c + 1], v2 = DIR ? X[61 - c] : X[c + 2], v3 = DIR ? X[60 - c] : X[c + 3];
      *(u32x2*)(ud + ((((lane >> 4) * 4 + m) * 64 + qd * 16 + (lane & 15)) * 8)) = (u32x2){pk2(v0, v1), pk2(v2, v3)};
    }
}
template <int DIR>
DI void dn_store_w(const float (&X)[64], bf16_t* wd, int lane) {
#pragma unroll
  for (int i = 0; i < 64; ++i) { const int c = DIR ? 63 - i : i; wd[c * 68 + lane] = f2bf(-X[i]); }
}
DI void dn_prep(const Params& p, int layer, int cgi, int h, unsigned char* lds) {
  int tid = threadIdx.x; asm volatile("" : "+v"(tid)); const int wid = tid >> 6, lane = tid & 63;
  bf16_t* proj = (bf16_t*)(p.ws + WS_PROJ);
  const int t0 = cgi * 64; int s0, S; seq_bounds(t0, s0, S);
  float* k32 = (float*)lds; float* v32 = k32 + 4096; float* q32 = v32 + 4096;
  float* Lf = (float*)(lds + 32768); float* Lb = Lf + 64 * 68;
  bf16_t* qb = (bf16_t*)(lds + 49152); bf16_t* kb = qb + 64 * 72;
  bf16_t* Wt = (bf16_t*)lds;
  float* gv = (float*)(lds + 72192);
  unsigned char* ops = p.ws + WS_OPS + (size_t)(cgi * 4 + h) * OPS_STRIDE;
  bf16_t* stg = (bf16_t*)(lds + 32768);
#pragma unroll
  for (int i = 0; i < 7; ++i) {
    const int ch = tid + 256 * i;
    if (ch < 1632) {
      const int tr = ch / 24, rem = ch - tr * 24, m = rem >> 3, c8 = rem & 7, tt = t0 - 2 + tr;
      u32x4 v = {0u, 0u, 0u, 0u};
      if (tt >= s0 && tt < s0 + S) v = *(const u32x4*)(proj + (size_t)tt * PP + B_Q + m * 256 + h * 64 + c8 * 8);
      *(u32x4*)(stg + tr * 200 + m * 64 + c8 * 8) = v;
    }
  }
  __syncthreads();
  {
    const int c = tid >> 2, sub = tid & 3;
    const float* cw = p.conv_w + (size_t)layer * 5 * 768;
    float res[3][16];
#pragma unroll
    for (int m = 0; m < 3; ++m) {
#pragma unroll
      for (int e = 0; e < 16; ++e) res[m][e] = 0.f;
      const int chb = m * 256 + h * 64 + sub * 16;
#pragma unroll
      for (int tap = 0; tap < 5; ++tap) {
        const bf16_t* src = stg + (c + tap) * 200 + m * 64 + sub * 16;
        const u32x4 v0 = *(const u32x4*)src, v1 = *(const u32x4*)(src + 8);
        float x[16]; unpack8(v0, x); unpack8(v1, x + 8);
        const float* w = cw + tap * 768 + chb;
#pragma unroll
        for (int e4 = 0; e4 < 4; ++e4) { const f32x4 wv = *(const f32x4*)(w + 4 * e4); res[m][4 * e4] += x[4 * e4] * wv.x; res[m][4 * e4 + 1] += x[4 * e4 + 1] * wv.y; res[m][4 * e4 + 2] += x[4 * e4 + 2] * wv.z; res[m][4 * e4 + 3] += x[4 * e4 + 3] * wv.w; }
      }
      float ss = 0.f;
#pragma unroll
      for (int e = 0; e < 16; ++e) { res[m][e] = silu(res[m][e]); ss += res[m][e] * res[m][e]; }
      if (m < 2) {
        ss += __shfl_xor(ss, 1); ss += __shfl_xor(ss, 2);
        float rn = rsqrtf(ss + EPSF); if (m == 0) rn *= 0.125f;
#pragma unroll
        for (int e = 0; e < 16; ++e) res[m][e] *= rn;
      }
    }
    __syncthreads();
#pragma unroll
    for (int m = 0; m < 3; ++m) {
      float* d32 = m == 0 ? q32 : (m == 1 ? k32 : v32);
#pragma unroll
      for (int e4 = 0; e4 < 4; ++e4) *(f32x4*)(d32 + c * 64 + sub * 16 + 4 * e4) = (f32x4){res[m][4 * e4], res[m][4 * e4 + 1], res[m][4 * e4 + 2], res[m][4 * e4 + 3]};
      if (m < 2) {
        bf16_t* db = m == 0 ? qb : kb;
        *(u32x4*)(db + c * 72 + sub * 16) = (u32x4){pk2(res[m][0], res[m][1]), pk2(res[m][2], res[m][3]), pk2(res[m][4], res[m][5]), pk2(res[m][6], res[m][7])};
        *(u32x4*)(db + c * 72 + sub * 16 + 8) = (u32x4){pk2(res[m][8], res[m][9]), pk2(res[m][10], res[m][11]), pk2(res[m][12], res[m][13]), pk2(res[m][14], res[m][15])};
      }
    }
  }
  if (tid < 64) {
    const bf16_t* row = proj + (size_t)(t0 + tid) * PP;
    float beta[2], g[2];
#pragma unroll
    for (int d = 0; d < 2; ++d) {
      const float braw = bf2f(row[B_BETA + d * 4 + h]), araw = bf2f(row[B_ALPHA + d * 4 + h]);
      beta[d] = 1.f / (1.f + __expf(-braw));
      const float xx = araw + p.dt_bias[layer * 8 + d * 4 + h];
      const float sp = fmaxf(xx, 0.f) + log1pf(__expf(-fabsf(xx)));
      g[d] = -__expf(p.a_log[layer * 8 + d * 4 + h]) * sp;
    }
    float gf = g[0], gb = g[1];
#pragma unroll
    for (int o = 1; o < 64; o <<= 1) { const float vf = __shfl_up(gf, o), vb = __shfl_down(gb, o); if (lane >= o) gf += vf; if (lane + o < 64) gb += vb; }
    gv[tid] = beta[0]; gv[64 + tid] = beta[1]; gv[128 + tid] = gf; gv[192 + tid] = gb;
    const float egf = __expf(gf), egb = __expf(gb);
    gv[256 + tid] = egf; gv[320 + tid] = egb;
    const float glf = __shfl(gf, 63), glb = __shfl(gb, 0);
    float* vec = (float*)(ops + 65536);
    vec[tid] = egf; vec[64 + tid] = __expf(glf - gf); vec[128 + tid] = egb; vec[192 + tid] = __expf(glb - gb);
  }
  __syncthreads();
#pragma unroll
  for (int it = 0; it < 2; ++it) {
    const int sl = tid + it * 256, tl = sl >> 6, ln = sl & 63, mt = tl >> 1, s = tl & 1, quad = ln >> 4, r16 = ln & 15;
    const int rr = 16 * mt + r16, kb0 = 32 * s + 4 * quad;
    const f32x4 a = *(const f32x4*)(q32 + rr * 64 + kb0), b = *(const f32x4*)(q32 + rr * 64 + kb0 + 16);
    *(u32x4*)(ops + sl * 16) = (u32x4){pk2(a.x, a.y), pk2(a.z, a.w), pk2(b.x, b.y), pk2(b.z, b.w)};
    float e[8];
#pragma unroll
    for (int j = 0; j < 8; ++j) e[j] = k32[(kb0 + 16 * (j >> 2) + (j & 3)) * 64 + rr];
    *(u32x4*)(ops + 8192 + sl * 16) = (u32x4){pk2(e[0], e[1]), pk2(e[2], e[3]), pk2(e[4], e[5]), pk2(e[6], e[7])};
  }
  const int dir = wid >> 1, isW = wid & 1;
  f32x4 ckk[4], cqk[4];
#pragma unroll
  for (int m = 0; m < 4; ++m) { ckk[m] = (f32x4){0.f, 0.f, 0.f, 0.f}; cqk[m] = (f32x4){0.f, 0.f, 0.f, 0.f}; }
  const int n16 = lane & 15, quad = lane >> 4;
#pragma unroll
  for (int ks = 0; ks < 2; ++ks) {
    const bf16x8 bq = *(const bf16x8*)(qb + (16 * wid + n16) * 72 + 32 * ks + 8 * quad);
    const bf16x8 bk = *(const bf16x8*)(kb + (16 * wid + n16) * 72 + 32 * ks + 8 * quad);
#pragma unroll
    for (int m = 0; m < 4; ++m) {
      const bf16x8 ak = *(const bf16x8*)(kb + (16 * m + n16) * 72 + 32 * ks + 8 * quad);
      cqk[m] = mfma16(ak, bq, cqk[m]);
      ckk[m] = mfma16(ak, bk, ckk[m]);
    }
  }
  __syncthreads();
  {
    const int i = 16 * wid + n16;
    const float gfi = gv[128 + i], gbi = gv[192 + i], bfi = gv[i], bbi = gv[64 + i];
    f32x4 af[4], ab[4];
#pragma unroll
    for (int m = 0; m < 4; ++m) {
      const f32x4 gfj = *(const f32x4*)(gv + 128 + 16 * m + 4 * quad), gbj = *(const f32x4*)(gv + 192 + 16 * m + 4 * quad);
      f32x4 lf, lb;
#pragma unroll
      for (int jj = 0; jj < 4; ++jj) {
        const int jp = 16 * m + 4 * quad + jj;
        const float df = __expf(gfi - gfj[jj]), db = __expf(gbi - gbj[jj]);
        af[m][jj] = (i >= jp) ? cqk[m][jj] * df : 0.f;
        lf[jj] = (i > jp) ? bfi * ckk[m][jj] * df : 0.f;
        ab[m][jj] = (i <= jp) ? cqk[m][jj] * db : 0.f;
        lb[jj] = (i < jp) ? bbi * ckk[m][jj] * db : 0.f;
      }
      *(f32x4*)(Lf + i * 68 + 16 * m + 4 * quad) = lf;
      *(f32x4*)(Lb + (63 - i) * 68 + 60 - 16 * m - 4 * quad) = (f32x4){lb[3], lb[2], lb[1], lb[0]};
    }
#pragma unroll
    for (int s = 0; s < 2; ++s) {
      *(bf16x8*)(ops + 16384 + 8192 + ((wid * 2 + s) * 64 + lane) * 16) = pack8(af[2 * s], af[2 * s + 1]);
      *(bf16x8*)(ops + 16384 + 24576 + 8192 + ((wid * 2 + s) * 64 + lane) * 16) = pack8(ab[2 * s], ab[2 * s + 1]);
    }
  }
  float X[64];
  int cb = dir ? 63 : 0, cs = dir ? -1 : 1;
  unsigned soff = isW ? 0u : 16384u, goff = dir ? 64u : 0u;
  asm volatile("" : "+v"(cb), "+v"(cs), "+v"(soff), "+v"(goff));
  {
    const float* srcp = (const float*)(lds + soff) + lane;
    const float* gp = gv + goff;
#pragma unroll
    for (int i = 0; i < 64; ++i) {
      const int c = cb + cs * i;
      const float eg = gp[256 + c];
      X[i] = gp[c] * srcp[c * 64] * (isW ? eg : 1.f);
      if ((i & 15) == 15) asm volatile("" ::: "memory");
    }
  }
  __syncthreads();
  {
    unsigned loff = dir ? 32768u + 64u * 68u * 4u : 32768u;
    asm volatile("" : "+v"(loff));
    const float* L = (const float*)(lds + loff);
    dn_solve_rows<1>(X, L);
  }
  if (isW == 0) {
    unsigned char* ud = ops + 16384 + dir * 24576 + 16384;
#pragma unroll
    for (int m = 0; m < 4; ++m)
#pragma unroll
      for (int qd = 0; qd < 4; ++qd) {
        const int c = 16 * m + 4 * qd;
        const float v0 = dir ? X[63 - c] : X[c], v1 = dir ? X[62 - c] : X[c + 1], v2 = dir ? X[61 - c] : X[c + 2], v3 = dir ? X[60 - c] : X[c + 3];
        *(u32x2*)(ud + ((((lane >> 4) * 4 + m) * 64 + qd * 16 + (lane & 15)) * 8)) = (u32x2){pk2(v0, v1), pk2(v2, v3)};
      }
  } else {
    bf16_t* wd = Wt + dir * 64 * 68 + lane;
#pragma unroll
    for (int i = 0; i < 64; ++i) { const int c = cb + cs * i; wd[c * 68] = f2bf(-X[i]); }
  }
  __syncthreads();
#pragma unroll
  for (int it = 0; it < 4; ++it) {
    const int sl = tid + 256 * it, d = sl >> 9, s9 = sl & 511, tl = s9 >> 6, ln = s9 & 63, mt = tl >> 1, s = tl & 1, qd = ln >> 4, r16 = ln & 15;
    const bf16_t* src = Wt + d * 64 * 68 + (16 * mt + r16) * 68 + 32 * s + 4 * qd;
    const u32x2 lo = *(const u32x2*)src, hi = *(const u32x2*)(src + 16);
    *(u32x4*)(ops + 16384 + d * 24576 + s9 * 16) = (u32x4){lo.x, lo.y, hi.x, hi.y};
  }
  __syncthreads();
}

DI void dn_scan(const Params& p, int chain, unsigned char* lds) {
  int tid = threadIdx.x; asm volatile("" : "+v"(tid)); const int wid = tid >> 6, lane = tid & 63, n16 = lane & 15, quad = lane >> 4;
  int seqi, h, dir;
  if (chain < 16) { seqi = chain >> 3; h = (chain >> 1) & 3; dir = chain & 1; } else { const int cc = chain - 16; seqi = 2 + (cc >> 3); h = (cc >> 1) & 3; dir = cc & 1; }
  const int s0 = seqi < 2 ? seqi * 16384 : T_PROMPT + (seqi - 2) * 4096, S = seqi < 2 ? 16384 : 4096, nch = S / 64, cg0 = s0 / 64;
  bf16_t* proj = (bf16_t*)(p.ws + WS_PROJ);
  u32x4 st[11];
#define SC_PREFETCH(cgi_) do { const unsigned char* o_ = p.ws + WS_OPS + (size_t)((cgi_) * 4 + h) * OPS_STRIDE; \
    _Pragma("unroll") for (int i_ = 0; i_ < 4; ++i_) st[i_] = *(const u32x4*)(o_ + (tid + 256 * i_) * 16); \
    _Pragma("unroll") for (int i_ = 0; i_ < 6; ++i_) st[4 + i_] = *(const u32x4*)(o_ + 16384 + dir * 24576 + (tid + 256 * i_) * 16); \
    if (tid < 32) st[10] = *(const u32x4*)(o_ + 65536 + dir * 512 + tid * 16); } while (0)
  bf16_t* obuf = (bf16_t*)(lds + 41984);
  const int ocolb = (dir ? B_K : B_Q) + 64 * h;
#define SC_FLUSH(cprev_) do { _Pragma("unroll") for (int i_ = 0; i_ < 2; ++i_) { const int c_ = tid + 256 * i_, row_ = c_ >> 3, ch_ = c_ & 7; \
    *(u32x4*)(proj + (size_t)(s0 + (cprev_) * 64 + row_) * PP + ocolb + ch_ * 8) = *(const u32x4*)(obuf + row_ * 72 + ch_ * 8); } } while (0)
  f32x4 Sacc[4];
#pragma unroll
  for (int m = 0; m < 4; ++m) Sacc[m] = (f32x4){0.f, 0.f, 0.f, 0.f};
  SC_PREFETCH(cg0 + (dir ? nch - 1 : 0));
  for (int step = 0; step < nch; ++step) {
    const int ci = dir ? nch - 1 - step : step;
    __syncthreads();
    if (step > 0) SC_FLUSH(dir ? ci + 1 : ci - 1);
#pragma unroll
    for (int i = 0; i < 4; ++i) *(u32x4*)(lds + (tid + 256 * i) * 16) = st[i];
#pragma unroll
    for (int i = 0; i < 6; ++i) *(u32x4*)(lds + 16384 + (tid + 256 * i) * 16) = st[4 + i];
    if (tid < 32) *(u32x4*)(lds + 40960 + tid * 16) = st[10];
    __syncthreads();
    if (step + 1 < nch) SC_PREFETCH(cg0 + (dir ? ci - 1 : ci + 1));
    const float* eg = (const float*)(lds + 40960); const float* ekd = eg + 64;
    bf16x8 Sb[2];
#pragma unroll
    for (int s = 0; s < 2; ++s) Sb[s] = pack8(Sacc[2 * s], Sacc[2 * s + 1]);
    f32x4 vn[4], qs[4];
#pragma unroll
    for (int m = 0; m < 4; ++m) {
      const u32x2 u = *(const u32x2*)(lds + 32768 + ((wid * 4 + m) * 64 + lane) * 8);
      vn[m] = (f32x4){bflo(u.x), bfhi(u.x), bflo(u.y), bfhi(u.y)};
      qs[m] = (f32x4){0.f, 0.f, 0.f, 0.f};
#pragma unroll
      for (int s = 0; s < 2; ++s) {
        const bf16x8 aw = *(const bf16x8*)(lds + 16384 + ((m * 2 + s) * 64 + lane) * 16);
        vn[m] = mfma16(aw, Sb[s], vn[m]);
        const bf16x8 aq = *(const bf16x8*)(lds + ((m * 2 + s) * 64 + lane) * 16);
        qs[m] = mfma16(aq, Sb[s], qs[m]);
      }
    }
    f32x4 egv[4], v2[4];
#pragma unroll
    for (int m = 0; m < 4; ++m) { egv[m] = *(const f32x4*)(eg + 16 * m + 4 * quad); const f32x4 ek = *(const f32x4*)(ekd + 16 * m + 4 * quad); v2[m] = vn[m] * ek; }
    bf16x8 vb[2], vb2[2];
#pragma unroll
    for (int s = 0; s < 2; ++s) { vb[s] = pack8(vn[2 * s], vn[2 * s + 1]); vb2[s] = pack8(v2[2 * s], v2[2 * s + 1]); }
    const float egl = dir ? eg[0] : eg[63];
#pragma unroll
    for (int m = 0; m < 4; ++m) {
      f32x4 o = qs[m] * egv[m];
      f32x4 sn = Sacc[m] * egl;
#pragma unroll
      for (int s = 0; s < 2; ++s) {
        if (dir ? !(s == 0 && m >= 2) : !(s == 1 && m < 2)) {
          const bf16x8 aa = *(const bf16x8*)(lds + 24576 + ((m * 2 + s) * 64 + lane) * 16);
          o = mfma16(aa, vb[s], o);
        }
        const bf16x8 ak = *(const bf16x8*)(lds + 8192 + ((m * 2 + s) * 64 + lane) * 16);
        sn = mfma16(ak, vb2[s], sn);
      }
      Sacc[m] = sn;
#pragma unroll
      for (int j = 0; j < 4; ++j) obuf[(16 * m + 4 * quad + j) * 72 + 16 * wid + n16] = f2bf(o[j]);
    }
  }
#undef SC_PREFETCH
  __syncthreads();
  SC_FLUSH(dir ? 0 : nch - 1);
#undef SC_FLUSH
  __syncthreads();
}

DI void attn_prep(const Params& p, int layer, int tile) {
  int tid = threadIdx.x; asm volatile("" : "+v"(tid)); const int c = tid >> 2, sub = tid & 3, t = tile * 64 + c;
  int s0, S; seq_bounds(t, s0, S); const int pos = t - s0;
  const int pa = (sub >> 1) ? (pos & 63) : (pos >> 6);
  const f32x2* tab = (const f32x2*)(p.ws + WS_ROPE) + pa * 16;
  bf16_t* row = (bf16_t*)(p.ws + WS_PROJ) + (size_t)t * PP;
  f32x2 cs[16];
#pragma unroll
  for (int e = 0; e < 16; ++e) cs[e] = tab[e];
#pragma unroll
  for (int hd = 0; hd < 6; ++hd) {
    bf16_t* ptr = row + (hd < 4 ? C_Q + 64 * hd : C_K + 64 * (hd - 4)) + sub * 16;
    const float* w = (hd < 4 ? p.q_norm_w : p.k_norm_w) + layer * 64 + sub * 16;
    const u32x4 v0 = *(const u32x4*)ptr, v1 = *(const u32x4*)(ptr + 8);
    float x[16]; unpack8(v0, x); unpack8(v1, x + 8);
    float ss = 0.f;
#pragma unroll
    for (int e = 0; e < 16; ++e) ss += x[e] * x[e];
    ss += __shfl_xor(ss, 1); ss += __shfl_xor(ss, 2);
    const float rn = rsqrtf(ss * (1.f / 64.f) + EPSF);
    const float sc = hd < 4 ? 0.125f * 1.4426950408889634f : 1.f;
    float y[16];
#pragma unroll
    for (int e = 0; e < 16; ++e) {
      const float v = x[e] * rn * w[e];
      const float pr = __shfl_xor(v, 1);
      y[e] = ((sub & 1) ? v * cs[e].x + pr * cs[e].y : v * cs[e].x - pr * cs[e].y) * sc;
    }
    *(u32x4*)ptr = (u32x4){pk2(y[0], y[1]), pk2(y[2], y[3]), pk2(y[4], y[5]), pk2(y[6], y[7])};
    *(u32x4*)(ptr + 8) = (u32x4){pk2(y[8], y[9]), pk2(y[10], y[11]), pk2(y[12], y[13]), pk2(y[14], y[15])};
  }
}

DI void attn_unit(const Params& p, int unit, unsigned char* lds) {
  int tid = threadIdx.x; asm volatile("" : "+v"(tid)); const int wid = tid >> 6, lane = tid & 63, r = lane & 31, hh = lane >> 5;
  int seqi, kvh, kvc, qblk;
  if (unit < 2048) { qblk = unit & 127; const int g = unit >> 7; kvc = g & 3; kvh = (g >> 2) & 1; seqi = g >> 3; }
  else { const int u = unit - 2048; qblk = u & 31; const int g = u >> 5; kvh = g & 1; seqi = 2 + (g >> 1); kvc = 0; }
  const int s0 = seqi < 2 ? seqi * 16384 : T_PROMPT + (seqi - 2) * 4096;
  const int tq0 = s0 + qblk * 128 + 32 * wid, kt0 = s0 + kvc * 4096;
  bf16_t* proj = (bf16_t*)(p.ws + WS_PROJ);
  bf16_t* Ks = (bf16_t*)lds; bf16_t* Vs = Ks + 2 * 64 * 72;
  bf16x8 Qf[2][4];
#pragma unroll
  for (int g = 0; g < 2; ++g)
#pragma unroll
    for (int ks = 0; ks < 4; ++ks) Qf[g][ks] = *(const bf16x8*)(proj + (size_t)(tq0 + r) * PP + C_Q + 64 * (2 * kvh + g) + 16 * ks + 8 * hh);
  f32x16 O[2][2];
#pragma unroll
  for (int a = 0; a < 2; ++a)
#pragma unroll
    for (int b = 0; b < 2; ++b)
#pragma unroll
      for (int i = 0; i < 16; ++i) O[a][b][i] = 0.f;
  float lsum[2] = {0.f, 0.f};
  u32x4 rk[2], rv[2];
  const int skey = tid >> 3, sdc = (tid & 7) * 8;
#define AT_LOAD(tl_) do { _Pragma("unroll") for (int i_ = 0; i_ < 2; ++i_) { const bf16_t* b_ = proj + (size_t)(kt0 + (tl_) * 64 + skey + 32 * i_) * PP + 64 * kvh + sdc; \
    rk[i_] = *(const u32x4*)(b_ + C_K); rv[i_] = *(const u32x4*)(b_ + C_V); } } while (0)
#define AT_STORE(buf_) do { _Pragma("unroll") for (int i_ = 0; i_ < 2; ++i_) { *(u32x4*)(Ks + (buf_) * 64 * 72 + (skey + 32 * i_) * 72 + sdc) = rk[i_]; \
    *(u32x4*)(Vs + (buf_) * 64 * 72 + (skey + 32 * i_) * 72 + sdc) = rv[i_]; } } while (0)
  AT_LOAD(0); AT_STORE(0); __syncthreads();
  const int gi = (lane >> 4) & 1, qq = (lane & 15) >> 2, pp = lane & 3;
  const int troff = (4 * hh + qq) * 72 + 16 * gi + 4 * pp;
  for (int tl = 0; tl < 64; ++tl) {
    { const int tn_ = tl + 1 < 64 ? tl + 1 : 63; AT_LOAD(tn_); }
    asm volatile("" ::: "memory"); __builtin_amdgcn_sched_barrier(0);
    const bf16_t* k_ = Ks + (tl & 1) * 64 * 72; const bf16_t* v_ = Vs + (tl & 1) * 64 * 72;
#pragma unroll
    for (int kt = 0; kt < 2; ++kt) {
      f32x16 Sx[2];
      f32x16 zero16;
#pragma unroll
      for (int i = 0; i < 16; ++i) zero16[i] = 0.f;
#pragma unroll
      for (int ks = 0; ks < 4; ++ks) {
        const bf16x8 kf = *(const bf16x8*)(k_ + (32 * kt + r) * 72 + 16 * ks + 8 * hh);
#pragma unroll
        for (int g = 0; g < 2; ++g) Sx[g] = mfma32(kf, Qf[g][ks], ks == 0 ? zero16 : Sx[g]);
      }
      bf16x8 vf[2][2];
#pragma unroll
      for (int s = 0; s < 2; ++s)
#pragma unroll
        for (int dt = 0; dt < 2; ++dt) {
          const bf16_t* vb_ = v_ + (32 * kt + 16 * s) * 72 + 32 * dt + troff;
          const s16x4 lo = __builtin_amdgcn_ds_read_tr16_b64_v4i16((LAS s16x4*)(vb_));
          const s16x4 hi = __builtin_amdgcn_ds_read_tr16_b64_v4i16((LAS s16x4*)(vb_ + 8 * 72));
          vf[s][dt] = __builtin_shufflevector(lo, hi, 0, 1, 2, 3, 4, 5, 6, 7);
        }
#pragma unroll
      for (int g = 0; g < 2; ++g) {
        float pv[16];
#pragma unroll
        for (int i = 0; i < 16; ++i) { pv[i] = __builtin_amdgcn_exp2f(Sx[g][i]); lsum[g] += pv[i]; }
        bf16x8 Pb[2];
#pragma unroll
        for (int s = 0; s < 2; ++s) {
          const u32x4 w = {pk2(pv[8 * s], pv[8 * s + 1]), pk2(pv[8 * s + 2], pv[8 * s + 3]), pk2(pv[8 * s + 4], pv[8 * s + 5]), pk2(pv[8 * s + 6], pv[8 * s + 7])};
          Pb[s] = __builtin_bit_cast(bf16x8, w);
        }
#pragma unroll
        for (int s = 0; s < 2; ++s)
#pragma unroll
          for (int dt = 0; dt < 2; ++dt) O[dt][g] = mfma32(vf[s][dt], Pb[s], O[dt][g]);
      }
    }
    if (tl + 1 < 64) AT_STORE((tl + 1) & 1);
    __syncthreads();
  }
#undef AT_LOAD
#undef AT_STORE
  const int pcol = kvc == 0 ? A_V : (kvc == 1 ? A_Z : (kvc == 2 ? B_V : D_X));
  float* lbuf = (float*)(p.ws + WS_LBUF);
#pragma unroll
  for (int g = 0; g < 2; ++g) {
    const float l = lsum[g] + __shfl_xor(lsum[g], 32);
    const int hq = 2 * kvh + g;
    if (hh == 0) lbuf[((size_t)kvc * T_TOK + tq0 + r) * 4 + hq] = l;
    u32x2 own[2][4];
#pragma unroll
    for (int dt = 0; dt < 2; ++dt)
#pragma unroll
      for (int gq = 0; gq < 4; ++gq) own[dt][gq] = (u32x2){pk2(O[dt][g][4 * gq], O[dt][g][4 * gq + 1]), pk2(O[dt][g][4 * gq + 2], O[dt][g][4 * gq + 3])};
    u32x4 outv[4];
#pragma unroll
    for (int gq = 0; gq < 4; ++gq) {
      const u32x2 give = hh ? own[0][gq] : own[1][gq];
      u32x2 got; got.x = (unsigned)__shfl_xor((int)give.x, 32); got.y = (unsigned)__shfl_xor((int)give.y, 32);
      const u32x2 keep = hh ? own[1][gq] : own[0][gq];
      outv[gq] = hh ? (u32x4){got.x, got.y, keep.x, keep.y} : (u32x4){keep.x, keep.y, got.x, got.y};
    }
    bf16_t* dst = proj + (size_t)(tq0 + r) * PP + pcol + 64 * hq + 32 * hh;
#pragma unroll
    for (int gq = 0; gq < 4; ++gq) *(u32x4*)(dst + 8 * gq) = outv[gq];
  }
}

DI void sgu_task(const Params& p, int layer, int chunk, int h, unsigned char* lds) {
  int tid = threadIdx.x; asm volatile("" : "+v"(tid)); const int wid = tid >> 6, lane = tid & 63, r = lane & 31, hh = lane >> 5;
  const int t0 = chunk * 128;
  bf16_t* proj = (bf16_t*)(p.ws + WS_PROJ);
  bf16_t* vT = (bf16_t*)lds;
  {
    const int j = tid >> 1, half = tid & 1;
    const bf16_t* src = proj + (size_t)(t0 + j) * PP + A_V + 64 * h + half * 32;
    float x[32];
#pragma unroll
    for (int i = 0; i < 4; ++i) unpack8(*(const u32x4*)(src + 8 * i), x + 8 * i);
    float ss = 0.f;
#pragma unroll
    for (int e = 0; e < 32; ++e) ss += x[e] * x[e];
    ss += __shfl_xor(ss, 1);
    const float rn = rsqrtf(ss * (1.f / 64.f) + EPSF);
#pragma unroll
    for (int e = 0; e < 32; ++e) vT[(half * 32 + e) * 136 + j] = f2bf(x[e] * rn);
  }
  __syncthreads();
  const bf16_t* W = (const bf16_t*)(p.ws + WS_SGUW) + ((size_t)(layer * 4 + h) * 128 + 32 * wid + r) * 128;
  f32x16 acc[2];
#pragma unroll
  for (int a = 0; a < 2; ++a)
#pragma unroll
    for (int i = 0; i < 16; ++i) acc[a][i] = 0.f;
#pragma unroll
  for (int ks = 0; ks < 8; ++ks) {
    const bf16x8 a = *(const bf16x8*)(W + 16 * ks + 8 * hh);
#pragma unroll
    for (int nt = 0; nt < 2; ++nt) { const bf16x8 b = *(const bf16x8*)(vT + (32 * nt + r) * 136 + 16 * ks + 8 * hh); acc[nt] = mfma32(a, b, acc[nt]); }
  }
  const float* bias = p.sgu_b + (layer * 4 + h) * 128;
  __syncthreads();
  {
    float* Ct = (float*)lds + wid * (32 * 68);
#pragma unroll
    for (int nt = 0; nt < 2; ++nt)
#pragma unroll
      for (int i = 0; i < 16; ++i) Ct[crow(i, hh) * 68 + 32 * nt + r] = acc[nt][i] + bias[32 * wid + crow(i, hh)];
    asm volatile("s_waitcnt lgkmcnt(0)" ::: "memory");
    const int rsub = lane >> 4, c4 = (lane & 15) * 4;
#pragma unroll 4
    for (int j = 0; j < 8; ++j) {
      const int rl = 4 * j + rsub;
      const f32x4 cv = *(const f32x4*)(Ct + rl * 68 + c4);
      bf16_t* base = proj + (size_t)(t0 + 32 * wid + rl) * PP + 64 * h + c4;
      const u32x2 ur = *(const u32x2*)(base + A_U), zr = *(const u32x2*)(base + A_Z);
      *(u32x2*)(base + A_U) = (u32x2){pk2(bflo(ur.x) * cv.x * silu(bflo(zr.x)), bfhi(ur.x) * cv.y * silu(bfhi(zr.x))), pk2(bflo(ur.y) * cv.z * silu(bflo(zr.y)), bfhi(ur.y) * cv.w * silu(bfhi(zr.y)))};
    }
  }
  __syncthreads();
}

DI void pool_task(const Params& p, int layer, int tile, unsigned char* lds) {
  int tid = threadIdx.x; asm volatile("" : "+v"(tid)); const int wid = tid >> 6, lane = tid & 63, r = lane & 31, hh = lane >> 5;
  const int g = wid, half = 1 << g, t0 = tile * 64; int s0, S; seq_bounds(t0, s0, S);
  bf16_t* proj = (bf16_t*)(p.ws + WS_PROJ);
  bf16_t* xs = (bf16_t*)lds + g * 80 * 72;
  for (int i = 0; i < 10; ++i) {
    const int c = lane + 64 * i, rr = c >> 3, dc = (c & 7) * 8, t = t0 - 8 + rr;
    u32x4 v = {0u, 0u, 0u, 0u};
    if (t >= s0 && t < s0 + S) v = *(const u32x4*)(proj + (size_t)t * PP + D_X + 64 * g + dc);
    *(u32x4*)(xs + rr * 72 + dc) = v;
  }
  __syncthreads();
  f32x16 acc[2][2];
#pragma unroll
  for (int a = 0; a < 2; ++a)
#pragma unroll
    for (int b = 0; b < 2; ++b)
#pragma unroll
      for (int i = 0; i < 16; ++i) acc[a][b][i] = 0.f;
  const bf16_t* WT = (const bf16_t*)(p.ws + WS_POOLW) + (size_t)(layer * 4 + g) * 4096;
#pragma unroll
  for (int mt = 0; mt < 2; ++mt) {
    const int tl = 32 * mt + r, pos = t0 + tl - s0;
    const int lo = max(pos - half, 0), hi = min(pos + half, S);
    const float inv = 1.f / (float)(hi - lo);
#pragma unroll
    for (int ks = 0; ks < 4; ++ks) {
      float sum[8];
#pragma unroll
      for (int e = 0; e < 8; ++e) sum[e] = 0.f;
      for (int w = 0; w < 2 * half; ++w) {
        float x[8]; unpack8(*(const u32x4*)(xs + (tl + 8 - half + w) * 72 + 16 * ks + 8 * hh), x);
#pragma unroll
        for (int e = 0; e < 8; ++e) sum[e] += x[e];
      }
      float x0[8]; unpack8(*(const u32x4*)(xs + (tl + 8) * 72 + 16 * ks + 8 * hh), x0);
      const u32x4 w4 = {pk2(sum[0] * inv - x0[0], sum[1] * inv - x0[1]), pk2(sum[2] * inv - x0[2], sum[3] * inv - x0[3]), pk2(sum[4] * inv - x0[4], sum[5] * inv - x0[5]), pk2(sum[6] * inv - x0[6], sum[7] * inv - x0[7])};
      const bf16x8 a = __builtin_bit_cast(bf16x8, w4);
#pragma unroll
      for (int nt = 0; nt < 2; ++nt) { const bf16x8 b = *(const bf16x8*)(WT + (32 * nt + r) * 64 + 16 * ks + 8 * hh); acc[mt][nt] = mfma32(a, b, acc[mt][nt]); }
    }
  }
  __syncthreads();
  {
    float* Ct = (float*)lds + wid * (64 * 68);
#pragma unroll
    for (int nt = 0; nt < 2; ++nt) {
      const float psc = p.pool_scale[layer * 256 + 64 * g + 32 * nt + r];
#pragma unroll
      for (int mt = 0; mt < 2; ++mt)
#pragma unroll
        for (int i = 0; i < 16; ++i) Ct[(32 * mt + crow(i, hh)) * 68 + 32 * nt + r] = acc[mt][nt][i] * psc;
    }
    asm volatile("s_waitcnt lgkmcnt(0)" ::: "memory");
    const int rsub = lane >> 4, c4 = (lane & 15) * 4;
#pragma unroll 4
    for (int j = 0; j < 16; ++j) {
      const int rl = 4 * j + rsub;
      const f32x4 cv = *(const f32x4*)(Ct + rl * 68 + c4);
      bf16_t* ptr = proj + (size_t)(t0 + rl) * PP + D_Z + 64 * g + c4;
      const u32x2 zr = *(const u32x2*)ptr;
      *(u32x2*)ptr = (u32x2){pk2(cv.x * silu(bflo(zr.x)), cv.y * silu(bfhi(zr.x))), pk2(cv.z * silu(bflo(zr.y)), cv.w * silu(bfhi(zr.y)))};
    }
  }
  __syncthreads();
}

DI void combine_task(const Params& p, int layer, int tile) {
  int tid = threadIdx.x; asm volatile("" : "+v"(tid)); const int c = tid >> 2, sub = tid & 3, t = tile * 64 + c;
  bf16_t* row = (bf16_t*)(p.ws + WS_PROJ) + (size_t)t * PP;
  const float* dnw = p.dn_norm_w + layer * 64 + sub * 16;
  const float* lbuf = (const float*)(p.ws + WS_LBUF);
  const int nparts = t < T_PROMPT ? 4 : 1;
#pragma unroll
  for (int h = 0; h < 4; ++h) {
    const int col = 64 * h + sub * 16;
    {
      float a[16], b[16], z[16];
      unpack8(*(const u32x4*)(row + B_Q + col), a); unpack8(*(const u32x4*)(row + B_Q + col + 8), a + 8);
      unpack8(*(const u32x4*)(row + B_K + col), b); unpack8(*(const u32x4*)(row + B_K + col + 8), b + 8);
      unpack8(*(const u32x4*)(row + B_Z + col), z); unpack8(*(const u32x4*)(row + B_Z + col + 8), z + 8);
      float ss = 0.f;
#pragma unroll
      for (int e = 0; e < 16; ++e) { a[e] += b[e]; ss += a[e] * a[e]; }
      ss += __shfl_xor(ss, 1); ss += __shfl_xor(ss, 2);
      const float rn = rsqrtf(ss * (1.f / 64.f) + EPSF);
      float y[16];
#pragma unroll
      for (int e = 0; e < 16; ++e) y[e] = a[e] * rn * dnw[e] * silu(z[e]);
      *(u32x4*)(row + B_Z + col) = (u32x4){pk2(y[0], y[1]), pk2(y[2], y[3]), pk2(y[4], y[5]), pk2(y[6], y[7])};
      *(u32x4*)(row + B_Z + col + 8) = (u32x4){pk2(y[8], y[9]), pk2(y[10], y[11]), pk2(y[12], y[13]), pk2(y[14], y[15])};
    }
    {
      float o[16], z[16], l = 0.f;
#pragma unroll
      for (int e = 0; e < 16; ++e) o[e] = 0.f;
#pragma unroll
      for (int pi = 0; pi < 4; ++pi) {
        const int pcol = pi == 0 ? A_V : (pi == 1 ? A_Z : (pi == 2 ? B_V : D_X));
        float a[16];
        unpack8(*(const u32x4*)(row + pcol + col), a); unpack8(*(const u32x4*)(row + pcol + col + 8), a + 8);
        const float lp = lbuf[((size_t)pi * T_TOK + t) * 4 + h];
        const bool use = pi < nparts;
#pragma unroll
        for (int e = 0; e < 16; ++e) o[e] += use ? a[e] : 0.f;
        l += use ? lp : 0.f;
      }
      unpack8(*(const u32x4*)(row + C_Z + col), z); unpack8(*(const u32x4*)(row + C_Z + col + 8), z + 8);
      const float il = 1.f / l;
      float y[16];
#pragma unroll
      for (int e = 0; e < 16; ++e) y[e] = o[e] * il * silu(z[e]);
      *(u32x4*)(row + C_Z + col) = (u32x4){pk2(y[0], y[1]), pk2(y[2], y[3]), pk2(y[4], y[5]), pk2(y[6], y[7])};
      *(u32x4*)(row + C_Z + col + 8) = (u32x4){pk2(y[8], y[9]), pk2(y[10], y[11]), pk2(y[12], y[13]), pk2(y[14], y[15])};
    }
  }
}


#define XB_TMO      128
#define XB_XCNT(j)  (256  + 64 * (j))
#define XB_XSUB(j)  (1280 + 64 * (j))
#define XB_XGEN(j)  (2304 + 64 * (j))
#define XB_TOP      3328
#define XB_TOPGEN   3392
#define XCD_BAR_WORDS 3456
#define XB_SPIN_CAP (1u << 20)
DI unsigned xb_ld(unsigned* p) { return __hip_atomic_load(p, __ATOMIC_RELAXED, __HIP_MEMORY_SCOPE_AGENT); }
DI unsigned xb_add(unsigned* p, unsigned v) { return __hip_atomic_fetch_add(p, v, __ATOMIC_RELAXED, __HIP_MEMORY_SCOPE_AGENT); }
#define XB_SPIN(cond, bar) do { unsigned _sp = 0; while (cond) { __builtin_amdgcn_s_sleep(1); \
    if ((++_sp & 255u) == 0u) { if (xb_ld(&(bar)[XB_TMO])) break; if (_sp > XB_SPIN_CAP) { atomicAdd(&(bar)[XB_TMO], 1u); break; } } } } while (0)
struct XcdBarrier { unsigned* bar; unsigned x; volatile unsigned* st; };
DI XcdBarrier xcd_barrier_post(unsigned* bar, volatile unsigned* st) {
  XcdBarrier b; b.bar = bar; b.x = xb_xcc_id(); b.st = st;
  if (threadIdx.x == 0) st[2] = xb_add(&bar[XB_XCNT(b.x)], 1u);
  return b;
}
DI void xcd_barrier_complete(unsigned* bar, unsigned x, unsigned& nloc, unsigned& nx) {
  const unsigned G = gridDim.x;
  unsigned sum, cnt, mine, sp = 0u;
  for (;;) {
    sum = 0u; cnt = 0u; mine = 0u;
#pragma unroll
    for (unsigned j = 0; j < 16; ++j) { const unsigned c = xb_ld(&bar[XB_XCNT(j)]); sum += c; cnt += (c > 0u) ? 1u : 0u; mine = (j == x) ? c : mine; }
    if (sum == G) break;
    __builtin_amdgcn_s_sleep(1);
    if ((++sp & 255u) == 0u) { if (xb_ld(&bar[XB_TMO])) break; if (sp > XB_SPIN_CAP) { atomicAdd(&bar[XB_TMO], 1u); break; } }
  }
  nloc = mine > 0u ? mine : 1u; nx = cnt > 0u ? cnt : 1u;
}
DI void xcd_barrier(const XcdBarrier& b) {
  asm volatile("s_waitcnt vmcnt(0)" ::: "memory");
  __syncthreads();
  if (threadIdx.x == 0) {
    unsigned* bar = b.bar;
    __builtin_amdgcn_s_waitcnt(0);
    unsigned nloc = b.st[0], nx = b.st[1];
    if (nloc == 0u) { xcd_barrier_complete(bar, b.x, nloc, nx); b.st[0] = nloc; b.st[1] = nx; }
    const unsigned old = xb_add(&bar[XB_XSUB(b.x)], 1u);
    const unsigned gen = old / nloc;
    if (old + 1u == (gen + 1u) * nloc) {
      __builtin_amdgcn_fence(__ATOMIC_RELEASE, "agent");
      asm volatile("s_waitcnt vmcnt(0)" ::: "memory");
      const unsigned og = xb_add(&bar[XB_TOP], 1u);
      const unsigned tg = og / nx;
      if (og + 1u == (tg + 1u) * nx) xb_add(&bar[XB_TOPGEN], 1u);
      else XB_SPIN(xb_ld(&bar[XB_TOPGEN]) == tg, bar);
      __builtin_amdgcn_fence(__ATOMIC_ACQUIRE, "agent");
      xb_add(&bar[XB_XGEN(b.x)], 1u);
      asm volatile("s_waitcnt vmcnt(0)" ::: "memory");
    } else {
      XB_SPIN(xb_ld(&bar[XB_XGEN(b.x)]) == gen, bar);
      __builtin_amdgcn_fence(__ATOMIC_ACQUIRE, "agent");
      asm volatile("s_waitcnt vmcnt(0)" ::: "memory");
    }
  }
  __syncthreads();
}

#ifndef PMASK
#define PMASK 0xffff
#endif
__global__ void __launch_bounds__(256, 2) mega(Params p) {
  extern __shared__ __attribute__((aligned(16))) unsigned char lds[];
  const int tid = threadIdx.x;
  volatile unsigned* bst = (volatile unsigned*)(lds + 73728 + 16);
  XcdBarrier xb{};
  if (tid == 0) { bst[0] = 0u; bst[1] = 0u; bst[2] = 0u; bst[3] = 0u; }
  if (p.coop) { __syncthreads(); xb = xcd_barrier_post((unsigned*)(p.ws + WS_BAR), bst); }
  for (int ph = p.ph_lo; ph < p.ph_hi; ++ph) {
    if (ph == 0) { if (PMASK & 1) phase0(p, lds); }
    else {
      const int layer = (ph - 1) / 5, sub = (ph - 1) % 5;
      if (sub == 0) { if (PMASK & 2) gemm_phase<0>(p, layer, lds); }
      else if (sub == 1) {
        for (int task = blockIdx.x; task < 6144; task += gridDim.x) {
          if (task < 3072) { if (PMASK & 4) dn_prep(p, layer, task >> 2, task & 3, lds); }
          else if (task < 3840) { if (PMASK & 8) attn_prep(p, layer, task - 3072); }
          else if (task < 5376) { if (PMASK & 16) sgu_task(p, layer, (task - 3840) >> 2, (task - 3840) & 3, lds); }
          else { if (PMASK & 32) pool_task(p, layer, task - 5376, lds); }
        }
      } else if (sub == 2) {
        if (PMASK & 64) for (int chain = blockIdx.x; chain < 48; chain += gridDim.x) dn_scan(p, chain, lds);
        int* cnt = (int*)(p.ws + WS_CNT) + layer;
        int* su = (int*)(lds + 73728);
        for (;;) {
          __syncthreads();
          if (tid == 0) *su = atomicAdd(cnt, 1);
          __syncthreads();
          const int u = *su;
          if (u >= N_ATT_UNITS) break;
          if (PMASK & 128) attn_unit(p, u, lds);
        }
      } else if (sub == 3) {
        if (PMASK & 256) for (int task = blockIdx.x; task < 768; task += gridDim.x) combine_task(p, layer, task);
      } else { if (PMASK & 512) gemm_phase<1>(p, layer, lds); }
    }
    if (p.coop && ph + 1 < p.ph_hi) { if (p.coop > 1) cg::this_grid().sync(); else xcd_barrier(xb); }
  }
}

extern "C" void kernel_launch(void* const* d_in, const int* in_sizes, int n_in, void* d_out, int out_size, void* d_ws, size_t ws_size, hipStream_t stream) {
  static int grid = 0, coop_ok = 1;
  if (grid == 0) {
    if (n_in != 15 || ws_size < WS_END || out_size != T_TOK * 1024) { fprintf(stderr, "kernel_launch: unexpected shapes (n_in %d, ws %zu need %zu, out %d)\n", n_in, ws_size, (size_t)WS_END, out_size); grid = -1; return; }
    int dev = 0, cus = 0, per_cu = 0;
    hipGetDevice(&dev);
    hipDeviceGetAttribute(&cus, hipDeviceAttributeMultiprocessorCount, dev);
    if (hipFuncSetAttribute((const void*)mega, hipFuncAttributeMaxDynamicSharedMemorySize, LDS_BYTES) != hipSuccess) { fprintf(stderr, "kernel_launch: hipFuncSetAttribute failed\n"); grid = -1; return; }
    if (hipOccupancyMaxActiveBlocksPerMultiprocessor(&per_cu, (const void*)mega, 256, LDS_BYTES) != hipSuccess || per_cu < 1) { fprintf(stderr, "kernel_launch: occupancy query failed (%d)\n", per_cu); per_cu = 1; (void)hipGetLastError(); }
    if (per_cu > 2) per_cu = 2;
    grid = cus * per_cu;
    fprintf(stderr, "kernel_launch: grid %d (%d CUs x %d)\n", grid, cus, per_cu);
  }
  if (grid < 0) return;
  Params p{};
  p.x_prompt = (const float*)d_in[0]; p.x_sample = (const float*)d_in[1]; p.norm_w = (const float*)d_in[2]; p.w_in = (const float*)d_in[3];
  p.sgu_w = (const float*)d_in[4]; p.sgu_b = (const float*)d_in[5]; p.conv_w = (const float*)d_in[6]; p.a_log = (const float*)d_in[7];
  p.dt_bias = (const float*)d_in[8]; p.dn_norm_w = (const float*)d_in[9]; p.q_norm_w = (const float*)d_in[10]; p.k_norm_w = (const float*)d_in[11];
  p.pool_w = (const float*)d_in[12]; p.pool_scale = (const float*)d_in[13]; p.w_out = (const float*)d_in[14];
  p.out = (float*)d_out; p.ws = (unsigned char*)d_ws;
  if (coop_ok) {
    p.ph_lo = 0; p.ph_hi = 11; p.coop = 1;
    if (hipMemsetAsync((char*)d_ws + WS_BAR, 0, 16384, stream) != hipSuccess) { fprintf(stderr, "kernel_launch: memset of barrier words failed\n"); return; }
    void* args[] = {&p};
    const hipError_t e = hipLaunchCooperativeKernel((const void*)mega, dim3(grid), dim3(256), args, LDS_BYTES, stream);
    if (e == hipSuccess) return;
    fprintf(stderr, "kernel_launch: cooperative launch failed: %s (grid %d); falling back to one launch per phase\n", hipGetErrorString(e), grid);
    (void)hipGetLastError();
    coop_ok = 0;
  }
  for (int ph = 0; ph < 11; ++ph) {
    p.ph_lo = ph; p.ph_hi = ph + 1; p.coop = 0;
    hipLaunchKernelGGL(mega, dim3(grid), dim3(256), LDS_BYTES, stream, p);
  }
}
```
